# Optimizing an MI355X kernel written in HIP

```python
import math
import jax, jax.numpy as jnp
from jax import lax
import numpy as np

D_MODEL = 4096
BATCH = 2
SEQ = 8192
DEPTH = 4

CHUNK = 64
Q_BLOCK = 128
MEM_LEN = 256
EPS = 1e-6
ROPE_THETA = 10000.0

A_HEADS = 16
A_NOPE = 128
A_ROPE = 64
A_QK = A_NOPE + A_ROPE
A_V = 128
A_WIDTH = A_HEADS * A_V
Q_LORA = 1024
KV_LORA = 512
B_HEADS = 8
B_DIM = 128
B_WIDTH = B_HEADS * B_DIM
M_HEADS = 4
M_DIM = 256
M_WIDTH = M_HEADS * M_DIM
N_BRANCH = 3

IN_SPLITS = (Q_LORA, KV_LORA, A_ROPE, A_WIDTH,
             3 * B_WIDTH, B_WIDTH,
             M_WIDTH, M_WIDTH,
             N_BRANCH * D_MODEL)
IN_COLS = sum(IN_SPLITS)

kernel_name = "hybrid_mla_stickbreak_mem_gated"


def rms_norm(x, g):
    xf = x.astype(jnp.float32)
    y = xf * lax.rsqrt(jnp.mean(xf * xf, axis=-1, keepdims=True) + EPS)
    return (y * g.astype(jnp.float32)).astype(x.dtype)


def rope(x, positions):
    half = x.shape[-1] // 2
    freqs = ROPE_THETA ** (-jnp.arange(half, dtype=jnp.float32) / half)
    ang = positions.astype(jnp.float32)[..., None] * freqs
    cos = jnp.cos(ang)[:, :, None, :]
    sin = jnp.sin(ang)[:, :, None, :]
    x1 = x[..., :half].astype(jnp.float32)
    x2 = x[..., half:].astype(jnp.float32)
    out = jnp.concatenate([x1 * cos - x2 * sin, x2 * cos + x1 * sin], axis=-1)
    return out.astype(x.dtype)


def to_blocks(t):
    b, s, h, d = t.shape
    return t.reshape(b, s // Q_BLOCK, Q_BLOCK, h, d).transpose(1, 0, 3, 2, 4)


def from_blocks(t):
    n, b, h, qb, d = t.shape
    return t.transpose(1, 0, 3, 2, 4).reshape(b, n * qb, h, d)


def chunk_causal_softmax_attention(q, k, v, scale):
    s_len = k.shape[1]
    kh = k.transpose(0, 2, 1, 3)
    vh = v.transpose(0, 2, 1, 3)
    k_chunk = jnp.arange(s_len) // CHUNK
    starts = jnp.arange(s_len // Q_BLOCK) * Q_BLOCK

    def one_block(args):
        qblk, start = args
        q_chunk = (start + jnp.arange(Q_BLOCK)) // CHUNK
        sc = jnp.einsum('bhqd,bhkd->bhqk', qblk, kh,
                        preferred_element_type=jnp.float32) * scale
        sc = jnp.where(k_chunk[None, :] <= q_chunk[:, None], sc, -jnp.inf)
        p = jax.nn.softmax(sc, axis=-1)
        return jnp.einsum('bhqk,bhkd->bhqd', p.astype(vh.dtype), vh)

    return from_blocks(lax.map(one_block, (to_blocks(q), starts)))


def stick_breaking_attention(q, k, v):
    s_len = k.shape[1]
    scale = 1.0 / math.sqrt(q.shape[-1])
    kh = k.transpose(0, 2, 1, 3)
    vh = v.transpose(0, 2, 1, 3)
    k_idx = jnp.arange(s_len)
    starts = jnp.arange(s_len // Q_BLOCK) * Q_BLOCK

    def one_block(args):
        qblk, start = args
        q_idx = start + jnp.arange(Q_BLOCK)
        z = jnp.einsum('bhqd,bhkd->bhqk', qblk, kh,
                       preferred_element_type=jnp.float32) * scale
        before = k_idx[None, :] < q_idx[:, None]
        log_beta = jax.nn.log_sigmoid(z)
        log_fail = jnp.where(before, jax.nn.log_sigmoid(-z), 0.0)
        later_fail = lax.cumsum(log_fail, axis=3, reverse=True) - log_fail
        w = jnp.where(before, jnp.exp(log_beta + later_fail), 0.0)
        return jnp.einsum('bhqk,bhkd->bhqd', w.astype(vh.dtype), vh)

    return from_blocks(lax.map(one_block, (to_blocks(q), starts)))


def memory_cross_attention(q, k, v):
    scale = 1.0 / math.sqrt(q.shape[-1])
    sc = jnp.einsum('bshd,bmhd->bhsm', q, k, preferred_element_type=jnp.float32) * scale
    p = jax.nn.softmax(sc, axis=-1)
    return jnp.einsum('bhsm,bmhd->bshd', p.astype(v.dtype), v)


def hybrid_layer(x, mem, positions, g_pre, w_in, g_q_lat, w_uq, g_kv_lat, w_ukv,
                 g_qn_a, g_kn_a, w_pa, w_pb, g_mem, w_mkv, g_qn_m, g_kn_m, w_pm, w_out):
    b, s, _ = x.shape
    h = rms_norm(x, g_pre)
    proj = h @ w_in
    cuts = [int(c) for c in np.cumsum(IN_SPLITS)[:-1]]
    c_q, c_kv, k_r, gate_a, qkv_b, gate_b, q_m, gate_m, merge = jnp.split(proj, cuts, axis=-1)

    q_a = (rms_norm(c_q, g_q_lat) @ w_uq).reshape(b, s, A_HEADS, A_QK)
    kv_a = (rms_norm(c_kv, g_kv_lat) @ w_ukv).reshape(b, s, A_HEADS, A_NOPE + A_V)
    k_nope, v_a = kv_a[..., :A_NOPE], kv_a[..., A_NOPE:]
    k_rope_shared = jnp.broadcast_to(k_r[:, :, None, :], (b, s, A_HEADS, A_ROPE))
    k_a = jnp.concatenate([k_nope, k_rope_shared], axis=-1)
    q_a = rms_norm(q_a, g_qn_a)
    k_a = rms_norm(k_a, g_kn_a)
    q_a = jnp.concatenate([q_a[..., :A_NOPE], rope(q_a[..., A_NOPE:], positions)], axis=-1)
    k_a = jnp.concatenate([k_a[..., :A_NOPE], rope(k_a[..., A_NOPE:], positions)], axis=-1)
    o_a = chunk_causal_softmax_attention(q_a, k_a, v_a, 1.0 / math.sqrt(A_QK))
    y_a = (o_a.reshape(b, s, A_WIDTH) * jax.nn.silu(gate_a)) @ w_pa

    qkv = qkv_b.reshape(b, s, 3, B_HEADS, B_DIM)
    o_b = stick_breaking_attention(qkv[:, :, 0], qkv[:, :, 1], qkv[:, :, 2])
    y_b = (o_b.reshape(b, s, B_WIDTH) * jax.nn.silu(gate_b)) @ w_pb

    kv_m = (rms_norm(mem, g_mem) @ w_mkv).reshape(b, mem.shape[1], 2, M_HEADS, M_DIM)
    q_mh = rms_norm(q_m.reshape(b, s, M_HEADS, M_DIM), g_qn_m)
    k_mh = rms_norm(kv_m[:, :, 0], g_kn_m)
    o_m = memory_cross_attention(q_mh, k_mh, kv_m[:, :, 1])
    y_m = (o_m.reshape(b, s, M_WIDTH) * jax.nn.silu(gate_m)) @ w_pm

    r = jax.nn.sigmoid(merge.reshape(b, s, N_BRANCH, D_MODEL))
    mixed = r[:, :, 0] * y_a + r[:, :, 1] * y_b + r[:, :, 2] * y_m
    return x + mixed @ w_out


def setup_inputs(seed: int = 0) -> dict:
    key = jax.random.key(seed)
    ks = jax.random.split(key, 20)
    f32 = jnp.float32

    def w(k, shape, fan_in):
        return jax.random.normal(k, shape, f32) * (fan_in ** -0.5)

    def gain(k, shape):
        return 1.0 + 0.01 * jax.random.normal(k, shape, f32)

    L = DEPTH
    return {
        "x": jax.random.normal(ks[0], (BATCH, SEQ, D_MODEL), f32),
        "mem": jax.random.normal(ks[1], (BATCH, MEM_LEN, D_MODEL), f32),
        "positions": jnp.broadcast_to(jnp.arange(SEQ, dtype=jnp.int32), (BATCH, SEQ)),
        "g_pre": gain(ks[2], (L, D_MODEL)),
        "w_in": w(ks[3], (L, D_MODEL, IN_COLS), D_MODEL),
        "g_q_lat": gain(ks[4], (L, Q_LORA)),
        "w_uq": w(ks[5], (L, Q_LORA, A_HEADS * A_QK), Q_LORA),
        "g_kv_lat": gain(ks[6], (L, KV_LORA)),
        "w_ukv": w(ks[7], (L, KV_LORA, A_HEADS * (A_NOPE + A_V)), KV_LORA),
        "g_qn_a": gain(ks[8], (L, A_QK)),
        "g_kn_a": gain(ks[9], (L, A_QK)),
        "w_pa": w(ks[10], (L, A_WIDTH, D_MODEL), A_WIDTH),
        "w_pb": w(ks[11], (L, B_WIDTH, D_MODEL), B_WIDTH),
        "g_mem": gain(ks[12], (L, D_MODEL)),
        "w_mkv": w(ks[13], (L, D_MODEL, 2 * M_WIDTH), D_MODEL),
        "g_qn_m": gain(ks[14], (L, M_DIM)),
        "g_kn_m": gain(ks[15], (L, M_DIM)),
        "w_pm": w(ks[16], (L, M_WIDTH, D_MODEL), M_WIDTH),
        "w_out": w(ks[17], (L, D_MODEL, D_MODEL), D_MODEL),
    }


def reference(x, mem, positions, g_pre, w_in, g_q_lat, w_uq, g_kv_lat, w_ukv,
              g_qn_a, g_kn_a, w_pa, w_pb, g_mem, w_mkv, g_qn_m, g_kn_m, w_pm, w_out):
    for l in range(DEPTH):
        x = hybrid_layer(x, mem, positions, g_pre[l], w_in[l], g_q_lat[l], w_uq[l],
                         g_kv_lat[l], w_ukv[l], g_qn_a[l], g_kn_a[l], w_pa[l], w_pb[l],
                         g_mem[l], w_mkv[l], g_qn_m[l], g_kn_m[l], w_pm[l], w_out[l])
    return x
```

```cpp
#include <hip/hip_runtime.h>
#include <cstdio>
#include <cstdint>
__device__ __forceinline__ int fresh_lane() { int l; asm volatile("v_mbcnt_lo_u32_b32 %0, -1, 0\n\tv_mbcnt_hi_u32_b32 %0, -1, %0" : "=v"(l)); return l; }
__device__ __forceinline__ float shflx(float v, int m) { return __int_as_float(__builtin_amdgcn_ds_bpermute((fresh_lane() ^ m) << 2, __float_as_int(v))); }
namespace pg8 {
#define PG8_LAS __attribute__((address_space(3)))
typedef unsigned short bf16_t;
typedef short bf16x8 __attribute__((ext_vector_type(8)));
typedef float f32x4 __attribute__((ext_vector_type(4)));
typedef unsigned u32x4 __attribute__((ext_vector_type(4)));
typedef int i32x4 __attribute__((ext_vector_type(4)));
typedef int i32x8 __attribute__((ext_vector_type(8)));
constexpr int BM = 256, BK = 64, HALF = 128, HTB = HALF * BK * 2  , STAGE_BYTES = 8 * HTB, NXCD = 8, WGM = 8;

__host__ __device__ __forceinline__ int lds_byte(int r, int c) { const int st = (r >> 4) * 2 + (c >> 5), rr = r & 15, cc = c & 31, ob = rr * 64 + cc * 2; return st * 1024 + (ob ^ (((ob >> 9) & 1) << 5)); }
__host__ __device__ __forceinline__ void stage_rc(int b, int& R, int& C) { const int st = b / 1024, sb = b % 1024, swz = sb ^ (((sb >> 9) & 1) << 5); R = (st >> 1) * 16 + swz / 64; C = (st & 1) * 32 + (swz % 64) / 2; }
__host__ __device__ __forceinline__ int perm32(int rho) { const int n = rho >> 4, i = rho & 15; return 8 * (i >> 2) + 4 * n + (i & 3); }

struct Unit { int pm, pn; };
struct Gemm { const bf16_t* A; const bf16_t* Bt; int M, N, K; int ld = 0; };

struct StaticOrder {
    int nM, nN, nwg, G, c;
    __host__ __device__ void init(int M, int N, int G_, int c_) { nM = M / BM; nN = N / BM; nwg = nM * nN; G = G_; c = c_; }
    __host__ __device__ bool next(int i, Unit& u) const {
        const long L = (long)i * G + c; if (L >= nwg) return false;
        int wgid = (int)L; { const int q = nwg / NXCD, r = nwg % NXCD, xcd = wgid % NXCD, off = wgid / NXCD; wgid = (xcd < r ? xcd * (q + 1) : r * (q + 1) + (xcd - r) * q) + off; }
        const int nig = WGM * nN, gid = wgid / nig, fm = gid * WGM, gsz = (nM - fm) < WGM ? (nM - fm) : WGM;
        u.pm = fm + ((wgid % nig) % gsz); u.pn = (wgid % nig) / gsz; return true;
    }
    __device__ __forceinline__ void a_ready(const Unit&) const {}
    __device__ __forceinline__ void done(const Unit&) const {}
};


struct TailOrder {
    int G, c;
    __device__ bool next(int i, Unit& u) const {
        const int base = G > 64 ? G - 64 : 0; if (c < base) return false;
        const int L = (c - base) + i * (G - base); if (L >= 64) return false;
        u.pm = L & 1; u.pn = L >> 1; return true;
    }
    __device__ __forceinline__ void a_ready(const Unit&) const {}
    __device__ __forceinline__ void done(const Unit&) const {}
};

typedef float f32x2v __attribute__((ext_vector_type(2)));
typedef __bf16 bf16x2v __attribute__((ext_vector_type(2)));
__device__ __forceinline__ unsigned cvt_pk_bf16(float lo, float hi) { f32x2v v = {lo, hi}; bf16x2v b = __builtin_convertvector(v, bf16x2v); return __builtin_bit_cast(unsigned, b); }
__device__ __forceinline__ float bf_lo(unsigned w) { return __uint_as_float(w << 16); }
__device__ __forceinline__ float bf_hi(unsigned w) { return __uint_as_float(w & 0xffff0000u); }
constexpr float LOG2E = 1.4426950408889634f;
__device__ __forceinline__ float sigmoid_f(float v) { return __builtin_amdgcn_rcpf(1.0f + __builtin_amdgcn_exp2f(-v * LOG2E)); }

__device__ __forceinline__ void row_scales(float (&rs)[8], const PG8_LAS float* tab, int wr, int fr) {
#pragma unroll
    for (int i = 0; i < 8; ++i) rs[i] = tab[wr * 64 + (i >> 2) * HALF + (i & 3) * 16 + fr];
}

template <bool F8> struct EpiPlainT {
    static constexpr bool FP8 = F8; static constexpr int MIXT = 0;
    static constexpr bool PERM = true, AFTER_DRAIN = false, HOOK = false; static constexpr int HOOK_T0 = -1, HOOK_T1 = -1;
    bf16_t* O; int ldc; const PG8_LAS float* rstab;
    __device__ __forceinline__ void mid(f32x4 (&)[2][2][4][2], const Unit&, int, int, int, int, int) const {}
    __device__ __forceinline__ void operator()(const f32x4 (&acc)[2][2][4][2], const Unit& u, int wr, int wc, int fr, int fq) const {
        int fr_ = fr, fq_ = fq; asm volatile("" : "+v"(fr_), "+v"(fq_));
        const int row0 = u.pm * BM + wr * 64 + fr_, col0 = u.pn * BM + wc * 32 + 8 * fq_;
        float rsv[8];
        if (rstab) row_scales(rsv, rstab, wr, fr_); else {
#pragma unroll
            for (int i = 0; i < 8; ++i) rsv[i] = 1.0f; }
#pragma unroll
        for (int ai = 0; ai < 2; ++ai)
#pragma unroll
            for (int m = 0; m < 4; ++m) { bf16_t* rowp = O + (size_t)(row0 + ai * HALF + m * 16) * ldc + col0;
                const float rs = rsv[ai * 4 + m];
#pragma unroll
                for (int bj = 0; bj < 2; ++bj) { const f32x4 v0 = acc[ai][bj][m][0] * rs, v1 = acc[ai][bj][m][1] * rs;
                    u32x4 w; w.x = cvt_pk_bf16(v0[0], v0[1]); w.y = cvt_pk_bf16(v0[2], v0[3]); w.z = cvt_pk_bf16(v1[0], v1[1]); w.w = cvt_pk_bf16(v1[2], v1[3]);
                    *(u32x4*)(rowp + bj * HALF) = w; } }
    }
};

using EpiPlain = EpiPlainT<false>;

typedef unsigned long long ssq_t;
constexpr float SSQ_FIX = 16777216.0f, SSQ_UNFIX = 1.0f / 16777216.0f;
__device__ __forceinline__ void ssq_add(ssq_t* p, float sq) { atomicAdd(p, (ssq_t)__float2ull_rn(sq * SSQ_FIX)); }
__device__ __forceinline__ float ssq_get(const ssq_t* p) { return (float)(*p) * SSQ_UNFIX; }

template <int ACT, bool OUT8 = false> __device__ __forceinline__ void epi_tile(const f32x4 (&acc)[2][2][4][2], bf16_t* base, int ldc, int row0, int cl, bool kr, ssq_t* ssqo, int fq, const float (&rsv)[8]) {
    const __amdgpu_buffer_rsrc_t rsd = __builtin_amdgcn_make_buffer_rsrc((void*)base, 0, -1, 0x00020000);
    const int vo = (row0 * ldc + cl) * (OUT8 ? 1 : 2);
#pragma unroll
    for (int ai = 0; ai < 2; ++ai)
#pragma unroll
        for (int m = 0; m < 4; ++m) {
            const float rs = rsv[ai * 4 + m]; float sq = 0.f;
#pragma unroll
            for (int bj = 0; bj < 2; ++bj) { if (kr && bj == 1) continue;
                f32x4 v0 = acc[ai][bj][m][0] * rs, v1 = acc[ai][bj][m][1] * rs;
                if (ACT == 0) sq += (v0[0] * v0[0] + v0[1] * v0[1]) + (v0[2] * v0[2] + v0[3] * v0[3]) + (v1[0] * v1[0] + v1[1] * v1[1]) + (v1[2] * v1[2] + v1[3] * v1[3]);
                if (ACT != 0) {
#pragma unroll
                    for (int e = 0; e < 4; ++e) { v0[e] *= sigmoid_f(v0[e]); v1[e] *= sigmoid_f(v1[e]); } }
                if constexpr (OUT8) { int p0 = __builtin_amdgcn_cvt_pk_fp8_f32(v0[0], v0[1], 0, false); p0 = __builtin_amdgcn_cvt_pk_fp8_f32(v0[2], v0[3], p0, true);
                    int p1 = __builtin_amdgcn_cvt_pk_fp8_f32(v1[0], v1[1], 0, false); p1 = __builtin_amdgcn_cvt_pk_fp8_f32(v1[2], v1[3], p1, true);
                    typedef unsigned u32x2 __attribute__((ext_vector_type(2)));
                    __builtin_amdgcn_raw_buffer_store_b64((u32x2){(unsigned)p0, (unsigned)p1}, rsd, vo + (ai * HALF + m * 16) * ldc + bj * HALF, 0, 0); }
                else {
                u32x4 w; w.x = cvt_pk_bf16(v0[0], v0[1]); w.y = cvt_pk_bf16(v0[2], v0[3]); w.z = cvt_pk_bf16(v1[0], v1[1]); w.w = cvt_pk_bf16(v1[2], v1[3]);
                __builtin_amdgcn_raw_buffer_store_b128(w, rsd, vo + (ai * HALF + m * 16) * ldc * 2 + bj * (HALF * 2), 0, 0); } }
            if (ACT == 0 && ssqo) { sq += shflx(sq, 16); sq += shflx(sq, 32); if (fq == 0) ssq_add(ssqo + row0 + ai * HALF + m * 16, sq); } }
}

__device__ __forceinline__ int pi32e(int i) { return (i & ~12) | ((i & 4) << 1) | ((i & 8) >> 1); }
__device__ __forceinline__ void epi_tile_kfrag(const f32x4 (&acc)[2][2][4][2], bf16_t* kfb, int pm, int pnk, int wr, int wc, int fr, int fq, const float (&rsv)[8]) {
    const __amdgpu_buffer_rsrc_t rsd = __builtin_amdgcn_make_buffer_rsrc((void*)kfb, 0, -1, 0x00020000);
    const int b = pm >> 5, tile0 = (pm & 31) * 8 + wr * 2, kk = wc * 2 + (fq >> 1), hi = fq & 1;
    const int vo = ((((b * 8 + pnk * 2) * 256 + tile0) * 8 + kk) * 64 + hi * 32 + pi32e(fr)) * 16;
#pragma unroll
    for (int ai = 0; ai < 2; ++ai)
#pragma unroll
        for (int m = 0; m < 4; ++m) { const float rs = rsv[ai * 4 + m];
#pragma unroll
            for (int bj = 0; bj < 2; ++bj) { const f32x4 v0 = acc[ai][bj][m][0] * rs, v1 = acc[ai][bj][m][1] * rs;
                u32x4 w; w.x = cvt_pk_bf16(v0[0], v0[1]); w.y = cvt_pk_bf16(v0[2], v0[3]); w.z = cvt_pk_bf16(v1[0], v1[1]); w.w = cvt_pk_bf16(v1[2], v1[3]);
                __builtin_amdgcn_raw_buffer_store_b128(w, rsd, vo + ai * 32768 + (m >> 1) * 8192 + (m & 1) * 256 + bj * 2097152, 0, 0); } }
}

template <class L> struct EpiIn {
    static constexpr bool FP8 = false; static constexpr int MIXT = 0;
    static constexpr bool PERM = true, AFTER_DRAIN = false, HOOK = false; static constexpr int HOOK_T0 = -1, HOOK_T1 = -1;
    unsigned char* ws; const PG8_LAS float* rstab;
    __device__ __forceinline__ void mid(f32x4 (&)[2][2][4][2], const Unit&, int, int, int, int, int) const {}
    __device__ __forceinline__ void operator()(const f32x4 (&acc)[2][2][4][2], const Unit& u, int wr, int wc, int fr, int fq) const {
        int fr_ = fr, fq_ = fq; asm volatile("" : "+v"(fr_), "+v"(fq_));
        const int pn = u.pn, row0 = u.pm * BM + wr * 64 + fr_, cl = wc * 32 + 8 * fq_;
        float rsv[8]; row_scales(rsv, rstab, wr, fr_);
        bf16_t* const GO = (bf16_t*)(ws + L::GO); bf16_t* const QKVB = (bf16_t*)(ws + L::QKVB); bf16_t* const QM = (bf16_t*)(ws + L::QM);
        if (pn >= 4 && pn < 8) epi_tile_kfrag(acc, (bf16_t*)(ws + L::KFB), u.pm, pn - 4, wr, wc, fr_, fq_, rsv);
        else if (pn < 12) epi_tile<0>(acc, QKVB, 3072, row0, pn * 256 + cl, false, nullptr, fq_, rsv);
        else if (pn < 16) epi_tile<1>(acc, GO, 4096, row0, 2048 + (pn - 12) * 256 + cl, false, nullptr, fq_, rsv);
        else if (pn < 20) epi_tile<0>(acc, QM, 1024, row0, (pn - 16) * 256 + cl, false, nullptr, fq_, rsv);
        else              epi_tile<1>(acc, GO, 4096, row0, 3072 + (pn - 20) * 256 + cl, false, nullptr, fq_, rsv);
    }
};

template <class L> struct EpiGate {
    static constexpr bool FP8 = true; static constexpr int MIXT = 0;
    static constexpr bool PERM = true, AFTER_DRAIN = false, HOOK = false; static constexpr int HOOK_T0 = -1, HOOK_T1 = -1;
    unsigned char* ws; const PG8_LAS float* rstab; int lrow;
    __device__ __forceinline__ void mid(f32x4 (&)[2][2][4][2], const Unit&, int, int, int, int, int) const {}
    __device__ __forceinline__ void operator()(const f32x4 (&acc)[2][2][4][2], const Unit& u, int wr, int wc, int fr, int fq) const {
        int fr_ = fr, fq_ = fq; asm volatile("" : "+v"(fr_), "+v"(fq_));
        float rsv[8]; row_scales(rsv, rstab, wr, fr_);
#pragma unroll
        for (int i = 0; i < 8; ++i) rsv[i] *= (1.0f / 64.0f);
        const int pn = u.pn;
        if (pn >= 48) { const int row0 = u.pm * BM + wr * 64 + fr_, cl = wc * 32 + 8 * fq_;
            bf16_t* const CQ = (bf16_t*)(ws + L::CQ); bf16_t* const CKV = (bf16_t*)(ws + L::CKV); bf16_t* const GO = (bf16_t*)(ws + L::GO); bf16_t* const KR = (bf16_t*)(ws + L::KR);
            ssq_t* const ssqq = (ssq_t*)(ws + L::SSQQ) + lrow; ssq_t* const ssqk = (ssq_t*)(ws + L::SSQK) + lrow;
            if (pn < 52)      epi_tile<0>(acc, CQ, 1024, row0, (pn - 48) * 256 + cl, false, ssqq, fq_, rsv);
            else if (pn < 54) epi_tile<0>(acc, CKV, 512, row0, (pn - 52) * 256 + cl, false, ssqk, fq_, rsv);
            else if (pn < 62) epi_tile<1>(acc, GO, 4096, row0, (pn - 54) * 256 + cl, false, nullptr, fq_, rsv);
            else { if (wc < 2) epi_tile<0>(acc, KR, 64, row0, cl, true, nullptr, fq_, rsv); }
            return; }
        bf16_t* bp = (bf16_t*)(ws + L::R) + ((((size_t)u.pm * 48 + pn) * 8 + (wr * 4 + wc)) * 16) * 512 + (size_t)(fq_ * 16 + fr_) * 8;
#pragma unroll
        for (int ai = 0; ai < 2; ++ai)
#pragma unroll
            for (int m = 0; m < 4; ++m) { const float rs = rsv[ai * 4 + m] * -LOG2E;
#define PG8_SG(t_) __builtin_amdgcn_exp2f(fminf(t_, 100.0f))
#pragma unroll
                for (int bj = 0; bj < 2; ++bj) { const f32x4 v0 = acc[ai][bj][m][0] * rs, v1 = acc[ai][bj][m][1] * rs; u32x4 w;
                    w.x = cvt_pk_bf16(PG8_SG(v0[0]), PG8_SG(v0[1])); w.y = cvt_pk_bf16(PG8_SG(v0[2]), PG8_SG(v0[3])); w.z = cvt_pk_bf16(PG8_SG(v1[0]), PG8_SG(v1[1])); w.w = cvt_pk_bf16(PG8_SG(v1[2]), PG8_SG(v1[3]));
                    *(u32x4*)(bp + (size_t)(((ai * 4 + m) * 2 + bj) * 512)) = w; } }
#undef PG8_SG
    }
};

struct EpiProj {
    static constexpr bool FP8 = false; static constexpr int MIXT = 16;
    static constexpr bool PERM = true, AFTER_DRAIN = false, HOOK = true; static constexpr int HOOK_T0 = 16, HOOK_T1 = 32;
    const bf16_t* R; bf16_t* O;
    __device__ __forceinline__ const bf16_t* blobp(const Unit& u, int branch, int wr, int wc, int fr, int fq) const {
        return R + ((((size_t)u.pm * 48 + (branch * 16 + u.pn)) * 8 + (wr * 4 + wc)) * 16) * 512 + (size_t)(fq * 16 + fr) * 8; }
    __device__ __forceinline__ void mid(f32x4 (&acc)[2][2][4][2], const Unit& u, int wr, int wc, int fr, int fq, int which) const {
        int fr_ = fr, fq_ = fq; asm volatile("" : "+v"(fr_), "+v"(fq_));
        const bf16_t* pa = blobp(u, which, wr, wc, fr_, fq_); const bf16_t* pb = pa + (size_t)16 * 8 * 16 * 512;
        const float sc_ = which ? 1.0f : (1.0f / 1024.0f);
#pragma unroll
        for (int ai = 0; ai < 2; ++ai) {
            u32x4 ra[8], rb[8];
#pragma unroll
            for (int q = 0; q < 8; ++q) { ra[q] = *(const u32x4*)(pa + (ai * 8 + q) * 512); rb[q] = *(const u32x4*)(pb + (ai * 8 + q) * 512); }
            __builtin_amdgcn_sched_barrier(0);
#pragma unroll
            for (int m = 0; m < 4; ++m)
#pragma unroll
                for (int bj = 0; bj < 2; ++bj) { const int q = m * 2 + bj;
#pragma unroll
                    for (int e = 0; e < 4; ++e) { const unsigned wa = ra[q][e], wb = rb[q][e];
                        const float f0 = (1.0f + bf_lo(wb)) * sc_ * __builtin_amdgcn_rcpf(1.0f + bf_lo(wa)), f1 = (1.0f + bf_hi(wb)) * sc_ * __builtin_amdgcn_rcpf(1.0f + bf_hi(wa));
                        if (e < 2) { acc[ai][bj][m][0][2 * e] *= f0; acc[ai][bj][m][0][2 * e + 1] *= f1; } else { acc[ai][bj][m][1][2 * (e - 2)] *= f0; acc[ai][bj][m][1][2 * (e - 2) + 1] *= f1; } } }
            __builtin_amdgcn_sched_barrier(0);
        }
    }
    __device__ __forceinline__ void operator()(const f32x4 (&acc)[2][2][4][2], const Unit& u, int wr, int wc, int fr, int fq) const {
        int fr_ = fr, fq_ = fq; asm volatile("" : "+v"(fr_), "+v"(fq_));
        const int row0 = u.pm * BM + wr * 64 + fr_, col0 = u.pn * BM + wc * 32 + 8 * fq_;
        const bf16_t* pc = blobp(u, 2, wr, wc, fr_, fq_);
        u32x4 rq[16];
#pragma unroll
        for (int q = 0; q < 16; ++q) rq[q] = *(const u32x4*)(pc + q * 512);
        __builtin_amdgcn_sched_barrier(0);
#pragma unroll
        for (int ai = 0; ai < 2; ++ai)
#pragma unroll
            for (int m = 0; m < 4; ++m) { bf16_t* op = O + (size_t)(row0 + ai * HALF + m * 16) * 4096 + col0;
#pragma unroll
                for (int bj = 0; bj < 2; ++bj) { const u32x4 rc = rq[(ai * 4 + m) * 2 + bj]; const f32x4 v0 = acc[ai][bj][m][0], v1 = acc[ai][bj][m][1];
                    u32x4 w;
#define PG8_R2(x_) __builtin_amdgcn_rcpf(1.0f + (x_))
                    w.x = cvt_pk_bf16(v0[0] * PG8_R2(bf_lo(rc.x)), v0[1] * PG8_R2(bf_hi(rc.x))); w.y = cvt_pk_bf16(v0[2] * PG8_R2(bf_lo(rc.y)), v0[3] * PG8_R2(bf_hi(rc.y)));
                    w.z = cvt_pk_bf16(v1[0] * PG8_R2(bf_lo(rc.z)), v1[1] * PG8_R2(bf_hi(rc.z))); w.w = cvt_pk_bf16(v1[2] * PG8_R2(bf_lo(rc.w)), v1[3] * PG8_R2(bf_hi(rc.w)));
#undef PG8_R2
                    *(u32x4*)(op + bj * HALF) = w; } }
    }
};

struct EpiOut {
    static constexpr bool FP8 = false; static constexpr int MIXT = 0;
    static constexpr bool PERM = true, AFTER_DRAIN = false, HOOK = false; static constexpr int HOOK_T0 = -1, HOOK_T1 = -1;
    const float* xin; float* out; bf16_t* xb; unsigned char* x8; ssq_t* ssqo;
    __device__ __forceinline__ void mid(f32x4 (&)[2][2][4][2], const Unit&, int, int, int, int, int) const {}
    __device__ __forceinline__ void operator()(const f32x4 (&acc)[2][2][4][2], const Unit& u, int wr, int wc, int fr, int fq) const {
        int fr_ = fr, fq_ = fq; asm volatile("" : "+v"(fr_), "+v"(fq_));
        const int row0 = u.pm * BM + wr * 64 + fr_, col0 = u.pn * BM + wc * 32 + 8 * fq_;
#pragma unroll
        for (int ai = 0; ai < 2; ++ai) {
            f32x4 xr[4][2][2];
#pragma unroll
            for (int m = 0; m < 4; ++m) { const size_t off = (size_t)(row0 + ai * HALF + m * 16) * 4096 + col0;
#pragma unroll
                for (int bj = 0; bj < 2; ++bj) { xr[m][bj][0] = *(const f32x4*)(xin + off + bj * HALF); xr[m][bj][1] = *(const f32x4*)(xin + off + bj * HALF + 4); } }
            __builtin_amdgcn_sched_barrier(0);
#pragma unroll
            for (int m = 0; m < 4; ++m) { const size_t off = (size_t)(row0 + ai * HALF + m * 16) * 4096 + col0; float sq = 0.f;
#pragma unroll
                for (int bj = 0; bj < 2; ++bj) { const f32x4 y0 = xr[m][bj][0] + acc[ai][bj][m][0], y1 = xr[m][bj][1] + acc[ai][bj][m][1];
                    *(f32x4*)(out + off + bj * HALF) = y0; *(f32x4*)(out + off + bj * HALF + 4) = y1;
                    if (xb) { u32x4 w; w.x = cvt_pk_bf16(y0[0], y0[1]); w.y = cvt_pk_bf16(y0[2], y0[3]); w.z = cvt_pk_bf16(y1[0], y1[1]); w.w = cvt_pk_bf16(y1[2], y1[3]); *(u32x4*)(xb + off + bj * HALF) = w;
                        { int p0 = __builtin_amdgcn_cvt_pk_fp8_f32(y0[0], y0[1], 0, false); p0 = __builtin_amdgcn_cvt_pk_fp8_f32(y0[2], y0[3], p0, true); int p1 = __builtin_amdgcn_cvt_pk_fp8_f32(y1[0], y1[1], 0, false); p1 = __builtin_amdgcn_cvt_pk_fp8_f32(y1[2], y1[3], p1, true);
                          typedef int i32x2 __attribute__((ext_vector_type(2))); *(i32x2*)(x8 + off + bj * HALF) = (i32x2){p0, p1}; }
                        sq += (y0[0] * y0[0] + y0[1] * y0[1]) + (y0[2] * y0[2] + y0[3] * y0[3]) + (y1[0] * y1[0] + y1[1] * y1[1]) + (y1[2] * y1[2] + y1[3] * y1[3]); } }
                if (xb) { sq += shflx(sq, 16); sq += shflx(sq, 32); if (fq_ == 0) ssq_add(ssqo + row0 + ai * HALF + m * 16, sq); } }
            __builtin_amdgcn_sched_barrier(0);
        }
    }
};

template <class Epi, class Sched, bool ALIGN_EPI = false, bool SP2 = false>
__device__ __forceinline__ void gemm_phase(PG8_LAS unsigned char* lds, const Gemm g, const Sched& S, const Epi& E, int tid_in) {
    int tid_ = tid_in; asm volatile("" : "+v"(tid_));
    const int tid = tid_, wid = __builtin_amdgcn_readfirstlane(tid >> 6), lane = tid & 63, wr = wid >> 2, wc = wid & 3, fr = lane & 15, fq = lane >> 4;
    const int K = g.K, LD = g.ld ? g.ld : g.K, nt = K / BK;
    unsigned voffA[2], voffB[2];
#pragma unroll
    for (int i = 0; i < 2; ++i) { int R, C; stage_rc(tid * 16 + i * 8192, R, C); const int Rb = Epi::PERM ? ((R & ~31) + perm32(R & 31)) : R;
        voffA[i] = (unsigned)(R * LD + C) * 2u; voffB[i] = (unsigned)(Rb * LD + C) * 2u; }
    const __amdgpu_buffer_rsrc_t rsA = __builtin_amdgcn_make_buffer_rsrc((void*)g.A, 0, -1, 0x00020000), rsB = __builtin_amdgcn_make_buffer_rsrc((void*)g.Bt, 0, -1, 0x00020000);
    const size_t kstep = (size_t)(BK * 2);
    const size_t hstep = (size_t)HALF * LD * 2;
    const size_t tstep = 2 * hstep;
    const unsigned ldsw = (unsigned)wid * 1024u;
    const int aoff = lds_byte(wr * 64 + fr, fq * 8), boff = lds_byte(wc * 32 + fr, fq * 8);
#define PG8_SA(b, h) (((b) * 2 + (h)) * HTB)
#define PG8_SB(b, h) ((4 + (b) * 2 + (h)) * HTB)
#define PG8_STAGE(bufoff, gbase, voff) do { const bool isA_ = (&(voff)[0] == &voffA[0]); const unsigned so_ = (unsigned)((const char*)(gbase) - (isA_ ? (const char*)g.A : (const char*)g.Bt)); \
        _Pragma("unroll") for (int _i = 0; _i < 2; ++_i) __builtin_amdgcn_raw_ptr_buffer_load_lds(isA_ ? rsA : rsB, (PG8_LAS unsigned*)(lds + (bufoff) + ldsw + _i * 8192), 16, (int)(voff)[_i], (int)so_, 0, 0); } while (0)
#define PG8_LD8(p_) __builtin_shufflevector(*(const PG8_LAS i32x4*)(p_), *(const PG8_LAS i32x4*)((p_) + 1024), 0, 1, 2, 3, 4, 5, 6, 7)
#define PG8_LDA(F8, dst, b, h) do { if constexpr (F8) { _Pragma("unroll") for (int m = 0; m < 4; ++m) dst##8[m] = PG8_LD8(lds + PG8_SA(b, h) + aoff + m * 2048); } \
        else { _Pragma("unroll") for (int m = 0; m < 4; ++m) _Pragma("unroll") for (int k = 0; k < 2; ++k) dst[m][k] = *(const PG8_LAS bf16x8*)(lds + PG8_SA(b, h) + aoff + m * 2048 + k * 1024); } } while (0)
#define PG8_LDB(F8, dst, b, h) do { if constexpr (F8) { _Pragma("unroll") for (int n = 0; n < 2; ++n) dst##8[n] = PG8_LD8(lds + PG8_SB(b, h) + boff + n * 2048); } \
        else { _Pragma("unroll") for (int n = 0; n < 2; ++n) _Pragma("unroll") for (int k = 0; k < 2; ++k) dst[n][k] = *(const PG8_LAS bf16x8*)(lds + PG8_SB(b, h) + boff + n * 2048 + k * 1024); } } while (0)
#define PG8_MMA(F8, ai, bj, At, Bt) do { __builtin_amdgcn_s_setprio(1); _Pragma("unroll") for (int m = 0; m < 4; ++m) _Pragma("unroll") for (int n = 0; n < 2; ++n) { \
        if constexpr (F8) acc[ai][bj][m][n] = __builtin_amdgcn_mfma_scale_f32_16x16x128_f8f6f4(Bt##8[n], At##8[m], acc[ai][bj][m][n], 0, 0, 0, 0, 0, 0);        \
        else { _Pragma("unroll") for (int k = 0; k < 2; ++k) acc[ai][bj][m][n] = __builtin_amdgcn_mfma_f32_16x16x32_bf16(Bt[n][k], At[m][k], acc[ai][bj][m][n], 0, 0, 0); } } \
        __builtin_amdgcn_s_setprio(0); } while (0)
#define PG8_WAIT_V(n) asm volatile("s_waitcnt vmcnt(" #n ")" ::: "memory")
#define PG8_WAIT_L(n) asm volatile("s_waitcnt lgkmcnt(" #n ")" ::: "memory")
#define PG8_BAR __builtin_amdgcn_s_barrier()
#define PG8_SCHED __builtin_amdgcn_sched_barrier(0)
#define PG8_KO(v) ((size_t)((Epi::MIXT > 0 && (v) >= Epi::MIXT) ? (v) + Epi::MIXT : (v)) * kstep)
#define PG8_KLOOP(F8_)         for (int t = tb_; t < te_; t += 2) { \
            const bool last = (t == nt - 2); \
            const char* a1 = cA + PG8_KO(t + 1); \
            const char* a2 = last ? nA : cA + PG8_KO(t + 2); const char* b2 = last ? nB : cB + PG8_KO(t + 2); \
            const char* a3 = a2 + kstep; const char* b3 = b2 + kstep; \
            if (last && has_next) S.a_ready(nxt); \
            if constexpr (SP2) { \
            PG8_LDB(F8_, B0, 0, 0); PG8_LDB(F8_, B1, 0, 1); PG8_SCHED; PG8_LDA(F8_, At, 0, 0); PG8_STAGE(PG8_SA(1, 1), a1 + hstep, voffA); \
            PG8_WAIT_V(8); PG8_WAIT_L(0); PG8_BAR; PG8_MMA(F8_, 0, 0, At, B0); PG8_MMA(F8_, 0, 1, At, B1); PG8_BAR; PG8_SCHED; \
            PG8_LDA(F8_, At, 0, 1); PG8_STAGE(PG8_SB(0, 0), b2, voffB); PG8_STAGE(PG8_SB(0, 1), b2 + hstep, voffB); PG8_STAGE(PG8_SA(0, 0), a2, voffA); \
            PG8_WAIT_V(8); PG8_WAIT_L(0); PG8_BAR; PG8_MMA(F8_, 1, 0, At, B0); PG8_MMA(F8_, 1, 1, At, B1); PG8_BAR; PG8_SCHED; \
            PG8_LDB(F8_, B0, 1, 0); PG8_LDB(F8_, B1, 1, 1); PG8_SCHED; PG8_LDA(F8_, At, 1, 0); PG8_STAGE(PG8_SA(0, 1), a2 + hstep, voffA); \
            PG8_WAIT_V(8); PG8_WAIT_L(0); PG8_BAR; PG8_MMA(F8_, 0, 0, At, B0); PG8_MMA(F8_, 0, 1, At, B1); PG8_BAR; PG8_SCHED; \
            PG8_LDA(F8_, At, 1, 1); PG8_STAGE(PG8_SB(1, 0), b3, voffB); PG8_STAGE(PG8_SB(1, 1), b3 + hstep, voffB); PG8_STAGE(PG8_SA(1, 0), a3, voffA); \
            PG8_WAIT_V(8); PG8_WAIT_L(0); PG8_BAR; PG8_MMA(F8_, 1, 0, At, B0); PG8_MMA(F8_, 1, 1, At, B1); PG8_BAR; PG8_SCHED; \
            } else { \
            PG8_LDB(F8_, B0, 0, 0); PG8_SCHED; PG8_LDA(F8_, At, 0, 0); PG8_STAGE(PG8_SA(1, 1), a1 + hstep, voffA); \
            PG8_WAIT_L(8); PG8_BAR; PG8_WAIT_L(0); PG8_MMA(F8_, 0, 0, At, B0); PG8_BAR; PG8_SCHED; \
            PG8_LDB(F8_, B1, 0, 1); PG8_STAGE(PG8_SB(0, 0), b2, voffB); \
            PG8_BAR; PG8_WAIT_L(0); PG8_MMA(F8_, 0, 1, At, B1); PG8_BAR; \
            PG8_LDA(F8_, At, 0, 1); PG8_STAGE(PG8_SA(0, 0), a2, voffA); \
            PG8_BAR; PG8_WAIT_L(0); PG8_MMA(F8_, 1, 0, At, B0); PG8_BAR; PG8_SCHED; \
            PG8_STAGE(PG8_SB(0, 1), b2 + hstep, voffB); \
            PG8_WAIT_V(6); PG8_BAR; PG8_MMA(F8_, 1, 1, At, B1); PG8_BAR; \
            PG8_LDB(F8_, B0, 1, 0); PG8_SCHED; PG8_LDA(F8_, At, 1, 0); PG8_STAGE(PG8_SA(0, 1), a2 + hstep, voffA); \
            PG8_WAIT_L(8); PG8_BAR; PG8_WAIT_L(0); PG8_MMA(F8_, 0, 0, At, B0); PG8_BAR; PG8_SCHED; \
            PG8_LDB(F8_, B1, 1, 1); PG8_STAGE(PG8_SB(1, 0), b3, voffB); \
            PG8_BAR; PG8_WAIT_L(0); PG8_MMA(F8_, 0, 1, At, B1); PG8_BAR; \
            PG8_LDA(F8_, At, 1, 1); PG8_STAGE(PG8_SA(1, 0), a3, voffA); \
            PG8_BAR; PG8_WAIT_L(0); PG8_MMA(F8_, 1, 0, At, B0); PG8_BAR; PG8_SCHED; \
            PG8_STAGE(PG8_SB(1, 1), b3 + hstep, voffB); \
            PG8_WAIT_V(6); PG8_BAR; PG8_MMA(F8_, 1, 1, At, B1); PG8_BAR; \
            } \
        }
    Unit cur, nxt; int ui = 0;
    if (!S.next(0, cur)) return;
    f32x4 acc[2][2][4][2];
#pragma unroll
    for (int a = 0; a < 2; ++a)
#pragma unroll
        for (int b = 0; b < 2; ++b)
#pragma unroll
            for (int m = 0; m < 4; ++m)
#pragma unroll
                for (int n = 0; n < 2; ++n) acc[a][b][m][n] = (f32x4){0.f, 0.f, 0.f, 0.f};
    bf16x8 At[4][2], B0[2][2], B1[2][2];
    i32x8 At8[4], B08[2], B18[2];
    const char* cA = (const char*)g.A + (size_t)cur.pm * tstep; const char* cB = (const char*)g.Bt + (size_t)cur.pn * tstep;
    S.a_ready(cur);
    if constexpr (SP2) {
        PG8_STAGE(PG8_SB(0, 0), cB, voffB); PG8_STAGE(PG8_SB(0, 1), cB + hstep, voffB); PG8_STAGE(PG8_SA(0, 0), cA, voffA); PG8_STAGE(PG8_SA(0, 1), cA + hstep, voffA);
        if (wr == 1) PG8_BAR;
        PG8_WAIT_V(2); PG8_BAR;
        PG8_STAGE(PG8_SB(1, 0), cB + kstep, voffB); PG8_STAGE(PG8_SA(1, 0), cA + kstep, voffA); PG8_STAGE(PG8_SB(1, 1), cB + hstep + kstep, voffB);
        PG8_WAIT_V(6); PG8_BAR;
    } else {
        PG8_STAGE(PG8_SB(0, 0), cB, voffB); PG8_STAGE(PG8_SA(0, 0), cA, voffA); PG8_STAGE(PG8_SB(0, 1), cB + hstep, voffB); PG8_STAGE(PG8_SA(0, 1), cA + hstep, voffA);
        if (wr == 1) PG8_BAR;
        PG8_WAIT_V(4); PG8_BAR;
        PG8_STAGE(PG8_SB(1, 0), cB + kstep, voffB); PG8_STAGE(PG8_SA(1, 0), cA + kstep, voffA); PG8_STAGE(PG8_SB(1, 1), cB + hstep + kstep, voffB);
        PG8_WAIT_V(6); PG8_BAR;
    }
    for (;;) {
        const bool has_next = S.next(ui + 1, nxt);
        const char* nA = has_next ? (const char*)g.A + (size_t)nxt.pm * tstep : cA; const char* nB = has_next ? (const char*)g.Bt + (size_t)nxt.pn * tstep : cB;
        if constexpr (Epi::MIXT > 0) {
            static_assert(Epi::HOOK && Epi::MIXT == Epi::HOOK_T0, "the e4m3 K-tiles are exactly the first segment");
            { const int tb_ = 0, te_ = Epi::HOOK_T0; PG8_KLOOP(true) }
            { int te2_ = fresh_lane(); asm volatile("" : "+v"(te2_)); E.mid(acc, cur, wr, wc, te2_ & 15, (te2_ >> 4) & 3, 0); }
            for (int seg = 1; seg < 3; ++seg) { const int tb_ = (seg == 1) ? Epi::HOOK_T0 : Epi::HOOK_T1, te_ = (seg == 1) ? Epi::HOOK_T1 : nt; PG8_KLOOP(false)
                if (seg == 1) { int te2_ = fresh_lane(); asm volatile("" : "+v"(te2_)); E.mid(acc, cur, wr, wc, te2_ & 15, (te2_ >> 4) & 3, 1); } }
        } else {
        constexpr int NSEG = Epi::HOOK ? 3 : 1; int tb_ = 0;
        for (int seg = 0; seg < NSEG; ++seg) { const int te_ = (NSEG == 1 || seg == 2) ? nt : (seg == 0 ? Epi::HOOK_T0 : Epi::HOOK_T1);
        PG8_KLOOP(Epi::FP8)
        if constexpr (Epi::HOOK) { if (seg < 2) { int te2_ = fresh_lane(); asm volatile("" : "+v"(te2_)); E.mid(acc, cur, wr, wc, te2_ & 15, (te2_ >> 4) & 3, seg); } } tb_ = te_; }
        }
        if constexpr (ALIGN_EPI) { if (wr == 0) PG8_BAR; }
        if constexpr (!Epi::AFTER_DRAIN) { int te2_ = fresh_lane(); asm volatile("" : "+v"(te2_)); E(acc, cur, wr, wc, te2_ & 15, (te2_ >> 4) & 3); S.done(cur); }
        if (!has_next) break;
#pragma unroll
        for (int a = 0; a < 2; ++a)
#pragma unroll
            for (int b = 0; b < 2; ++b)
#pragma unroll
                for (int m = 0; m < 4; ++m)
#pragma unroll
                    for (int n = 0; n < 2; ++n) acc[a][b][m][n] = (f32x4){0.f, 0.f, 0.f, 0.f};
        cur = nxt; cA = nA; cB = nB; ++ui;
        if constexpr (ALIGN_EPI) { if (wr == 1) PG8_BAR; }
    }
    PG8_WAIT_V(0);
    if constexpr (!ALIGN_EPI) { if (wr == 0) PG8_BAR; }
    PG8_BAR;
    if constexpr (Epi::AFTER_DRAIN) { E.fused(acc, cur, wr, wc, fr, fq, lds, wid, lane); S.done(cur); }
#undef PG8_SA
#undef PG8_SB
#undef PG8_STAGE
#undef PG8_LDA
#undef PG8_LDB
#undef PG8_MMA
#undef PG8_KLOOP
#undef PG8_KO
#undef PG8_LD8
#undef PG8_WAIT_V
#undef PG8_WAIT_L
#undef PG8_BAR
#undef PG8_SCHED
}
}

constexpr int BATCH = 2, SEQ = 8192, DM = 4096, DEPTH = 4, M = BATCH * SEQ;
constexpr int NIN = 22080;
constexpr int NB16 = 6144;
constexpr int NG8 = 16128;
constexpr int MEMLEN = 256;
constexpr float EPS = 1e-6f;
constexpr int NWAVES = 8, NTHREADS = 512;

constexpr size_t al256(size_t x) { return (x + 255) & ~(size_t)255; }
constexpr size_t WS_CTL = 0, CTL_ZERO_BYTES = 2u << 20;
constexpr size_t SZ_WIN = (size_t)NB16 * 4096 * 2, SZ_W8 = (size_t)NG8 * 4096, SZ_WUQ = (size_t)3072 * 1024 * 2, SZ_WUKV = (size_t)4096 * 512 * 2, SZ_WPROJ = (size_t)4096 * 4096 * 2, SZ_WOUT = (size_t)4096 * 4096 * 2;
constexpr size_t SZ_WMKV = (size_t)2048 * 4096 * 2;
constexpr size_t WL_WIN = 0, WL_W8 = WL_WIN + SZ_WIN, WL_WUQ = WL_W8 + SZ_W8, WL_WUKV = WL_WUQ + SZ_WUQ, WL_WPROJ = WL_WUKV + SZ_WUKV, WL_WOUT = WL_WPROJ + SZ_WPROJ, WL_STRIDE = WL_WOUT + SZ_WOUT;
constexpr size_t WS_W = CTL_ZERO_BYTES;
constexpr size_t WS_WMKV = WS_W + DEPTH * WL_STRIDE;
constexpr size_t WS_H = WS_WMKV + DEPTH * SZ_WMKV;
constexpr size_t WS_MEMN = WS_H + (size_t)M * 4096 * 2;
constexpr size_t WS_CQ = WS_MEMN + (size_t)512 * 4096 * 2;
constexpr size_t WS_CKV = WS_CQ + (size_t)M * 1024 * 2;
constexpr size_t WS_KR = WS_CKV + (size_t)M * 512 * 2;
constexpr size_t WS_GO = WS_KR + (size_t)M * 64 * 2;
constexpr size_t WS_QKVB = WS_GO + (size_t)M * 4096 * 2;
constexpr size_t WS_QM = WS_QKVB + (size_t)M * 3072 * 2;
constexpr size_t WS_R = WS_QM + (size_t)M * 1024 * 2;
constexpr size_t WS_QAR = WS_R + (size_t)M * 12288 * 2;
constexpr size_t WS_KVA = WS_QAR + (size_t)M * 3072 * 2;
constexpr size_t WS_QA = WS_KVA + (size_t)M * 4096 * 2;
constexpr size_t WS_KA = WS_QA + (size_t)M * 3072 * 2;
constexpr size_t WS_VTA = WS_KA + (size_t)M * 3072 * 2;
constexpr size_t WS_VTB = WS_VTA + (size_t)M * 2048 * 2;
constexpr size_t WS_QMN = WS_VTB + (size_t)M * 1024 * 2;
constexpr size_t WS_MIXB = WS_QMN + (size_t)M * 1024 * 2;
constexpr size_t WS_KVM = WS_MIXB + (size_t)M * 4096 * 2;
constexpr size_t WS_KM = WS_KVM + (size_t)512 * 8192 * 2;
constexpr size_t WS_VTM = WS_KM + (size_t)DEPTH * 2 * 4 * 256 * 256 * 2;
constexpr size_t WS_ROPE = WS_VTM + (size_t)DEPTH * 2 * 4 * 256 * 256 * 2;
constexpr size_t WS_OC = WS_ROPE + (size_t)M * 32 * 4 * 2;
constexpr size_t WS_XA = WS_OC + (size_t)M * 4096 * 2;
constexpr size_t WS_H8 = WS_XA + (size_t)M * 4096 * 4;
constexpr size_t WS_END = WS_H8 + (size_t)M * 4096;
static_assert(WS_W % 256 == 0 && WL_STRIDE % 256 == 0 && WS_END % 256 == 0, "ws map alignment");
constexpr size_t CTL_SSQX = 65536, CTL_SSQQ = CTL_SSQX + (size_t)DEPTH * M * 8, CTL_SSQK = CTL_SSQQ + (size_t)DEPTH * M * 8;
static_assert(CTL_SSQK + (size_t)DEPTH * M * 8 <= CTL_ZERO_BYTES, "row statistics inside the zeroed control region");
struct WsL { static constexpr size_t KFB = WS_KA + (size_t)M * 3072, CQ = WS_CQ, CKV = WS_CKV, KR = WS_KR, GO = WS_GO, QKVB = WS_QKVB, QM = WS_QM, R = WS_R, SSQQ = WS_CTL + CTL_SSQQ, SSQK = WS_CTL + CTL_SSQK; };
constexpr int CW_BAR = 4096;

constexpr int RING_BYTES = 131072;
constexpr int MISC_OFF = RING_BYTES + 320;
constexpr int RSTAB_OFF = RING_BYTES + 1024;
constexpr int LDS_BYTES = 147456;

#define GAS __attribute__((address_space(1)))
#define LAS __attribute__((address_space(3)))
typedef unsigned short bf16;
typedef unsigned v4u __attribute__((ext_vector_type(4)));
typedef unsigned v2u __attribute__((ext_vector_type(2)));
typedef float f32x4 __attribute__((ext_vector_type(4)));
typedef float f32x16 __attribute__((ext_vector_type(16)));
typedef short bf16x8 __attribute__((ext_vector_type(8)));
using pg8::cvt_pk_bf16; using pg8::bf_lo; using pg8::bf_hi; using pg8::LOG2E;
#define LDS_WAIT() asm volatile("s_waitcnt lgkmcnt(0)" ::: "memory")

#define XB_TMO      128
#define XB_XCNT(j)  (256  + 64 * (j))
#define XB_XSUB(j)  (1280 + 64 * (j))
#define XB_XGEN(j)  (2304 + 64 * (j))
#define XB_TOP      3328
#define XB_TOPGEN   3392
#define XCD_BAR_WORDS 3456
#define XB_SPIN_CAP (1u << 18)

__device__ __forceinline__ unsigned xb_ld(unsigned* p)              { return __hip_atomic_load(p, __ATOMIC_RELAXED, __HIP_MEMORY_SCOPE_AGENT); }
__device__ __forceinline__ unsigned xb_add(unsigned* p, unsigned v) { return __hip_atomic_fetch_add(p, v, __ATOMIC_RELAXED, __HIP_MEMORY_SCOPE_AGENT); }
__device__ __forceinline__ unsigned xb_xcc_id() { return (unsigned)__builtin_amdgcn_s_getreg((3 << 11) | 20) & 0xFu; }
#define XB_SPIN(cond, bar) do { unsigned _sp = 0; while (cond) { __builtin_amdgcn_s_sleep(1); \
    if ((++_sp & 255u) == 0u) { if (xb_ld(&(bar)[XB_TMO])) break; if (_sp > XB_SPIN_CAP) { atomicAdd(&(bar)[XB_TMO], 1u); break; } } } } while (0)

struct XcdBarrier {
    unsigned* bar; unsigned x; int w;
    volatile LAS unsigned* st;
};

__device__ __forceinline__ XcdBarrier xcd_barrier_post(unsigned* bar, volatile LAS unsigned* st, int wave) {
    XcdBarrier b; b.bar = bar; b.x = xb_xcc_id(); b.st = st; b.w = wave;
    if (threadIdx.x == 0) (void)xb_add(&bar[XB_XCNT(b.x)], 1u);
    return b;
}
__device__ __forceinline__ void xcd_barrier_complete(unsigned* bar, unsigned x, unsigned& nloc, unsigned& nx) {
    const unsigned G = gridDim.x * gridDim.y * gridDim.z;
    unsigned sum, cnt, mine, sp = 0u;
    for (;;) {
        sum = 0u; cnt = 0u; mine = 0u;
#pragma unroll
        for (unsigned j = 0; j < 16; ++j) { const unsigned c = xb_ld(&bar[XB_XCNT(j)]); sum += c; cnt += (c > 0u) ? 1u : 0u; mine = (j == x) ? c : mine; }
        if (sum == G) break;
        __builtin_amdgcn_s_sleep(1);
        if ((++sp & 255u) == 0u) { if (xb_ld(&bar[XB_TMO])) break; if (sp > XB_SPIN_CAP) { atomicAdd(&bar[XB_TMO], 1u); break; } }
    }
    nloc = mine > 0u ? mine : 1u; nx = cnt > 0u ? cnt : 1u;
}

__device__ __forceinline__ void xcd_barrier(const XcdBarrier& b) {
    asm volatile("s_waitcnt vmcnt(0)" ::: "memory");
    __syncthreads();
    if (b.w == 0 && fresh_lane() == 0) {
        unsigned bx_ = b.x; asm volatile("" : "+s"(bx_));
        unsigned* bar = b.bar; asm volatile("" : "+s"(bar));
        __builtin_amdgcn_s_waitcnt(0);
        unsigned nloc = b.st[0], nx = b.st[1];
        if (nloc == 0u) { xcd_barrier_complete(bar, bx_, nloc, nx); b.st[0] = nloc; b.st[1] = nx; }
        const unsigned old = xb_add(&bar[XB_XSUB(bx_)], 1u);
        const unsigned gen = old / nloc;
        if (old + 1u == (gen + 1u) * nloc) {
            __builtin_amdgcn_fence(__ATOMIC_RELEASE, "agent");
            asm volatile("s_waitcnt vmcnt(0)" ::: "memory");
            const unsigned og = xb_add(&bar[XB_TOP], 1u);
            const unsigned tg = og / nx;
            if (og + 1u == (tg + 1u) * nx) xb_add(&bar[XB_TOPGEN], 1u);
            else XB_SPIN(xb_ld(&bar[XB_TOPGEN]) == tg, bar);
            __builtin_amdgcn_fence(__ATOMIC_ACQUIRE, "agent");
            xb_add(&bar[XB_XGEN(bx_)], 1u);
            asm volatile("s_waitcnt vmcnt(0)" ::: "memory");
        } else {
            XB_SPIN(xb_ld(&bar[XB_XGEN(bx_)]) == gen, bar);
            __builtin_amdgcn_fence(__ATOMIC_ACQUIRE, "agent");
            asm volatile("s_waitcnt vmcnt(0)" ::: "memory");
        }
    }
    __syncthreads();
}

__device__ __forceinline__ float wave_sum(float v) {
#pragma unroll
    for (int o = 1; o < 64; o <<= 1) v += shflx(v, o);
    return v;
}
__device__ __forceinline__ float ssq8(v4u v) {
    float s = 0.f;
#pragma unroll
    for (int e = 0; e < 4; ++e) { const float a = bf_lo(v[e]), b = bf_hi(v[e]); s += a * a + b * b; }
    return s;
}
__device__ __forceinline__ int pi32(int i) { return (i & ~12) | ((i & 4) << 1) | ((i & 8) >> 1); }

struct TrDesc { const float* W; const float* gk; bf16* WT; size_t drow0; int N, k0, n0, ldk, koff, fp8; };
__device__ __forceinline__ void tr_load(const TrDesc& d, f32x4 (&v)[8], int lane) {
    const int kr = lane >> 3, n4 = (lane & 7) * 4;
#pragma unroll
    for (int i = 0; i < 8; ++i) v[i] = *(const f32x4*)(d.W + (size_t)(d.k0 + 8 * i + kr) * d.N + d.n0 + n4);
}
__device__ __forceinline__ void tr_finish(const TrDesc& d, const f32x4 (&v)[8], LAS float* scr, int lane) {
    { const int kr = lane >> 3, n4 = (lane & 7) * 4;
#pragma unroll
      for (int i = 0; i < 8; ++i) { LAS float* q = scr + (8 * i + kr) * 33 + n4; q[0] = v[i].x; q[1] = v[i].y; q[2] = v[i].z; q[3] = v[i].w; } }
    const int c = lane & 7;
    f32x4 g0 = {1.f, 1.f, 1.f, 1.f}, g1 = {1.f, 1.f, 1.f, 1.f};
    if (d.gk) { g0 = *(const f32x4*)(d.gk + d.k0 + 8 * c); g1 = *(const f32x4*)(d.gk + d.k0 + 8 * c + 4); }
    LDS_WAIT(); asm volatile("" ::: "memory");
    if (d.fp8) { g0 = g0 * 64.0f; g1 = g1 * 64.0f;
#pragma unroll
        for (int j = 0; j < 4; ++j) { const int n = (lane >> 3) + 8 * j; const LAS float* sp = scr + (8 * c) * 33 + n;
            int p0 = __builtin_amdgcn_cvt_pk_fp8_f32(sp[0 * 33] * g0.x, sp[1 * 33] * g0.y, 0, false); p0 = __builtin_amdgcn_cvt_pk_fp8_f32(sp[2 * 33] * g0.z, sp[3 * 33] * g0.w, p0, true);
            int p1 = __builtin_amdgcn_cvt_pk_fp8_f32(sp[4 * 33] * g1.x, sp[5 * 33] * g1.y, 0, false); p1 = __builtin_amdgcn_cvt_pk_fp8_f32(sp[6 * 33] * g1.z, sp[7 * 33] * g1.w, p1, true);
            *(v2u*)((unsigned char*)d.WT + (d.drow0 + n) * (size_t)d.ldk + d.k0 + 8 * c) = (v2u){(unsigned)p0, (unsigned)p1}; }
    } else {
#pragma unroll
    for (int j = 0; j < 4; ++j) { const int n = (lane >> 3) + 8 * j; const LAS float* sp = scr + (8 * c) * 33 + n;
        v4u o; o.x = cvt_pk_bf16(sp[0 * 33] * g0.x, sp[1 * 33] * g0.y); o.y = cvt_pk_bf16(sp[2 * 33] * g0.z, sp[3 * 33] * g0.w); o.z = cvt_pk_bf16(sp[4 * 33] * g1.x, sp[5 * 33] * g1.y); o.w = cvt_pk_bf16(sp[6 * 33] * g1.z, sp[7 * 33] * g1.w);
        *(v4u*)(d.WT + (d.drow0 + n) * (size_t)d.ldk + d.koff + d.k0 + 8 * c) = o; }
    }
    LDS_WAIT(); asm volatile("" ::: "memory");
}

__device__ __forceinline__ void transpose_64x64(const bf16* src, size_t spitch, bf16* dst, size_t dpitch, LAS unsigned char* scr, int lane) {
    const int p = lane & 7, t8 = lane >> 3;
    v4u v[8];
#pragma unroll
    for (int sub = 0; sub < 8; ++sub) v[sub] = *(const v4u*)(src + (size_t)(sub * 8 + t8) * spitch + 8 * p);
#pragma unroll
    for (int sub = 0; sub < 8; ++sub)
#pragma unroll
        for (int e = 0; e < 8; ++e) { const unsigned w = v[sub][e >> 1]; *(LAS unsigned short*)(scr + (8 * p + e) * 144 + (sub * 8 + t8) * 2) = (unsigned short)((e & 1) ? (w >> 16) : (w & 0xffffu)); }
    LDS_WAIT(); asm volatile("" ::: "memory");
#pragma unroll
    for (int i = 0; i < 8; ++i) { const int d = 8 * i + (lane >> 3), ch = lane & 7; const v4u x = *(const LAS v4u*)(scr + d * 144 + ch * 16); *(v4u*)(dst + (size_t)d * dpitch + 8 * ch) = x; }
    LDS_WAIT(); asm volatile("" ::: "memory");
}

__device__ __forceinline__ unsigned pk_fp8x4(float a, float b, float c, float d) { int p = __builtin_amdgcn_cvt_pk_fp8_f32(a, b, 0, false); p = __builtin_amdgcn_cvt_pk_fp8_f32(c, d, p, true); return (unsigned)p; }

__device__ __forceinline__ void transpose_64x64_f8(const bf16* src, size_t spitch, unsigned char* dst8, size_t dpitch, LAS unsigned char* scr, int lane) {
    const int p = lane & 7, t8 = lane >> 3;
    v4u v[8];
#pragma unroll
    for (int sub = 0; sub < 8; ++sub) v[sub] = *(const v4u*)(src + (size_t)(sub * 8 + t8) * spitch + 8 * p);
#pragma unroll
    for (int sub = 0; sub < 8; ++sub)
#pragma unroll
        for (int e = 0; e < 8; ++e) { const unsigned w = v[sub][e >> 1]; *(LAS unsigned short*)(scr + (8 * p + e) * 144 + (sub * 8 + t8) * 2) = (unsigned short)((e & 1) ? (w >> 16) : (w & 0xffffu)); }
    LDS_WAIT(); asm volatile("" ::: "memory");
#pragma unroll
    for (int i = 0; i < 8; ++i) { const int d = 8 * i + (lane >> 3), ch = lane & 7; const v4u x = *(const LAS v4u*)(scr + d * 144 + ch * 16);
        unsigned char* o8 = dst8 + (size_t)d * dpitch + 4 * ch;
        *(unsigned*)o8 = pk_fp8x4(bf_lo(x.x), bf_hi(x.x), bf_lo(x.y), bf_hi(x.y)); *(unsigned*)(o8 + 32) = pk_fp8x4(bf_lo(x.z), bf_hi(x.z), bf_lo(x.w), bf_hi(x.w)); }
    LDS_WAIT(); asm volatile("" ::: "memory");
}

__device__ __forceinline__ void transpose_64x64_frag(const bf16* src, size_t spitch, bf16* vf_bh, int tile0, int dh, LAS unsigned char* scr, int lane) {
    const int p = lane & 7, t8 = lane >> 3;
    v4u v[8];
#pragma unroll
    for (int sub = 0; sub < 8; ++sub) v[sub] = *(const v4u*)(src + (size_t)(sub * 8 + t8) * spitch + 8 * p);
#pragma unroll
    for (int sub = 0; sub < 8; ++sub)
#pragma unroll
        for (int e = 0; e < 8; ++e) { const unsigned w = v[sub][e >> 1]; *(LAS unsigned short*)(scr + (8 * p + e) * 144 + (sub * 8 + t8) * 2) = (unsigned short)((e & 1) ? (w >> 16) : (w & 0xffffu)); }
    LDS_WAIT(); asm volatile("" ::: "memory");
#pragma unroll
    for (int i = 0; i < 8; ++i) { const int d = 8 * i + (lane >> 3), ch = lane & 7; const v4u x = *(const LAS v4u*)(scr + d * 144 + ch * 16);
        const int db = dh * 2 + (d >> 5), r32 = d & 31, tl = ch >> 2, ks = (ch >> 1) & 1, hi = ch & 1;
        *(v4u*)(vf_bh + ((((size_t)(tile0 + tl) * 4 + db) * 2 + ks) * 64 + hi * 32 + r32) * 8) = x; }
    LDS_WAIT(); asm volatile("" ::: "memory");
}

template <int DQK, int NDB, bool FIXMAX, bool OUT8 = false>
__device__ __forceinline__ void attn_unit(const bf16* Qp, const bf16* Kp, const bf16* VTp, int vpitch, int NT, int cw, bool rev, const bf16* GOp, bf16* OCp, LAS unsigned char* lds, int tid_in) {
    int tid = tid_in; asm volatile("" : "+v"(tid));
    constexpr int KP = 2 * DQK + 16, VP = 144, VOFF = 64 * KP, BUF = VOFF + 32 * NDB * VP, CPR = DQK / 8, NKC = (64 * CPR) / 512, NKK = DQK / 16, NVC = NDB / 2;
    static_assert(2 * BUF <= RING_BYTES && (64 * CPR) % 512 == 0 && (NDB == 2 || NDB == 4), "attention LDS image");
    const int lane = tid & 63, wave = __builtin_amdgcn_readfirstlane(tid >> 6), r32 = lane & 31, hi = lane >> 5;
    bf16x8 qf[NKK];
#pragma unroll
    for (int kk = 0; kk < NKK; ++kk) qf[kk] = *(const bf16x8*)(Qp + (size_t)(wave * 32 + r32) * DQK + 16 * kk + 8 * hi);
    f32x16 o[NDB];
#pragma unroll
    for (int db = 0; db < NDB; ++db)
#pragma unroll
        for (int r = 0; r < 16; ++r) o[db][r] = 0.f;
    float m_run = -INFINITY, l_run = 0.f;
    const bf16* kg = Kp + 8 * tid; const bf16* vg = VTp + (size_t)(tid >> 3) * vpitch + 8 * (tid & 7);
#define AT_KL(t_, i) ((((t_) + 512 * (i)) / CPR) * KP + (((t_) + 512 * (i)) % CPR) * 16)
#define AT_VL(t_, i) (VOFF + (((t_) + 512 * (i)) >> 3) * VP + (((t_) + 512 * (i)) & 7) * 16)
    const int kfo = pi32(r32) * KP + 16 * hi, vfo = VOFF + r32 * VP + 16 * hi;
    v4u sk[NKC], sv[NVC];
    { const int tt0 = rev ? NT - 1 : 0;
#pragma unroll
    for (int i = 0; i < NKC; ++i) sk[i] = *(const v4u*)(kg + (size_t)tt0 * 64 * DQK + 4096 * i);
#pragma unroll
    for (int i = 0; i < NVC; ++i) sv[i] = *(const v4u*)(vg + (size_t)64 * i * vpitch + tt0 * 64); }
#pragma unroll
    for (int i = 0; i < NKC; ++i) *(LAS v4u*)(lds + AT_KL(tid, i)) = sk[i];
#pragma unroll
    for (int i = 0; i < NVC; ++i) *(LAS v4u*)(lds + AT_VL(tid, i)) = sv[i];
    __syncthreads();
    for (int t = 0; t < NT; ++t) {
        const bool more = (t + 1 < NT);
        const int tt = rev ? NT - 1 - t : t;
        if (more) { const int tn = rev ? tt - 1 : tt + 1;
#pragma unroll
            for (int i = 0; i < NKC; ++i) sk[i] = *(const v4u*)(kg + (size_t)tn * 64 * DQK + 4096 * i);
#pragma unroll
            for (int i = 0; i < NVC; ++i) sv[i] = *(const v4u*)(vg + (size_t)64 * i * vpitch + tn * 64);
        }
        if (tt <= cw) {
            LAS unsigned char* buf = lds + (t & 1) * BUF;
            f32x16 s0, s1;
#pragma unroll
            for (int r = 0; r < 16; ++r) { s0[r] = 0.f; s1[r] = 0.f; }
#define AT_KFRAG(i) (*(const LAS bf16x8*)(buf + kfo + ((i) & 1) * 32 * KP + 32 * ((i) >> 1)))
#define AT_VFRAG(i) (*(const LAS bf16x8*)(buf + vfo + 32 * ((i) >> 2) * VP + 32 * ((i) & 3)))
            bf16x8 ring[4];
            ring[0] = AT_KFRAG(0); ring[1] = AT_KFRAG(1); ring[2] = AT_KFRAG(2);
            __builtin_amdgcn_sched_barrier(0);
#pragma unroll
            for (int i = 0; i < 2 * NKK; ++i) {
                if (i + 3 < 2 * NKK) ring[(i + 3) & 3] = AT_KFRAG(i + 3);
                if (i & 1) s1 = __builtin_amdgcn_mfma_f32_32x32x16_bf16(ring[i & 3], qf[i >> 1], s1, 0, 0, 0); else s0 = __builtin_amdgcn_mfma_f32_32x32x16_bf16(ring[i & 3], qf[i >> 1], s0, 0, 0, 0);
                __builtin_amdgcn_sched_barrier(0);
            }
            ring[0] = AT_VFRAG(0); ring[1] = AT_VFRAG(1); ring[2] = AT_VFRAG(2);
            if constexpr (FIXMAX) {
                float ps = 0.f;
#pragma unroll
                for (int r = 0; r < 16; ++r) { s0[r] = __builtin_amdgcn_exp2f(s0[r]); s1[r] = __builtin_amdgcn_exp2f(s1[r]); ps += s0[r] + s1[r]; }
                l_run += ps;
            } else {
            float mx = fmaxf(s0[0], s1[0]);
#pragma unroll
            for (int r = 1; r < 16; ++r) mx = fmaxf(mx, fmaxf(s0[r], s1[r]));
            mx = fmaxf(mx, shflx(mx, 32));
            const float m_new = fmaxf(m_run, mx), alpha = __builtin_amdgcn_exp2f(m_run - m_new);
            float ps = 0.f;
#pragma unroll
            for (int r = 0; r < 16; ++r) { s0[r] = __builtin_amdgcn_exp2f(s0[r] - m_new); s1[r] = __builtin_amdgcn_exp2f(s1[r] - m_new); ps += s0[r] + s1[r]; }
            l_run = l_run * alpha + ps; m_run = m_new;
            if (__any(alpha != 1.0f)) {
#pragma unroll
                for (int db = 0; db < NDB; ++db)
#pragma unroll
                    for (int r = 0; r < 16; ++r) o[db][r] *= alpha;
            }
            }
            bf16x8 pf[4];
#pragma unroll
            for (int ks = 0; ks < 4; ++ks) { const f32x16& sx = (ks < 2) ? s0 : s1; const int b = (ks & 1) * 8; v4u w;
                w.x = cvt_pk_bf16(sx[b + 0], sx[b + 1]); w.y = cvt_pk_bf16(sx[b + 2], sx[b + 3]); w.z = cvt_pk_bf16(sx[b + 4], sx[b + 5]); w.w = cvt_pk_bf16(sx[b + 6], sx[b + 7]); pf[ks] = __builtin_bit_cast(bf16x8, w); }
            __builtin_amdgcn_sched_barrier(0);
#pragma unroll
            for (int i = 0; i < 4 * NDB; ++i) {
                if (i + 3 < 4 * NDB) ring[(i + 3) & 3] = AT_VFRAG(i + 3);
                o[i >> 2] = __builtin_amdgcn_mfma_f32_32x32x16_bf16(ring[i & 3], pf[i & 3], o[i >> 2], 0, 0, 0);
                __builtin_amdgcn_sched_barrier(0);
            }
#undef AT_KFRAG
#undef AT_VFRAG
        }
        if (more) {
            LAS unsigned char* nb = lds + ((t + 1) & 1) * BUF; int t_ = tid; asm volatile("" : "+v"(t_));
#pragma unroll
            for (int i = 0; i < NKC; ++i) *(LAS v4u*)(nb + AT_KL(t_, i)) = sk[i];
#pragma unroll
            for (int i = 0; i < NVC; ++i) *(LAS v4u*)(nb + AT_VL(t_, i)) = sv[i];
        }
        __syncthreads();
    }
    const float inv = (OUT8 ? 16.0f : 1.0f) / (l_run + shflx(l_run, 32));
    const bf16* gp = GOp + (size_t)(wave * 32 + r32) * 4096 + 4 * hi; bf16* op = OCp + (size_t)(wave * 32 + r32) * 4096 + 4 * hi;
#pragma unroll
    for (int db = 0; db < NDB; ++db)
#pragma unroll
        for (int g = 0; g < 4; ++g) { const bf16* p = gp + 32 * db + 8 * g; const v2u gv = *(const v2u*)p;
            const float y0 = o[db][4 * g + 0] * inv * bf_lo(gv.x), y1 = o[db][4 * g + 1] * inv * bf_hi(gv.x), y2 = o[db][4 * g + 2] * inv * bf_lo(gv.y), y3 = o[db][4 * g + 3] * inv * bf_hi(gv.y);
            if constexpr (OUT8) { float c0 = y0, c1 = y1, c2 = y2, c3 = y3;
                asm("v_min_f32 %0, 0x43e00000, %0\n\tv_max_f32 %0, 0xc3e00000, %0\n\tv_min_f32 %1, 0x43e00000, %1\n\tv_max_f32 %1, 0xc3e00000, %1\n\tv_min_f32 %2, 0x43e00000, %2\n\tv_max_f32 %2, 0xc3e00000, %2\n\tv_min_f32 %3, 0x43e00000, %3\n\tv_max_f32 %3, 0xc3e00000, %3" : "+v"(c0), "+v"(c1), "+v"(c2), "+v"(c3));
                int pk = __builtin_amdgcn_cvt_pk_fp8_f32(c0, c1, 0, false); pk = __builtin_amdgcn_cvt_pk_fp8_f32(c2, c3, pk, true);
                *(unsigned*)((unsigned char*)OCp + (size_t)(wave * 32 + r32) * 8192 + 4 * hi + 32 * db + 8 * g) = (unsigned)pk; }
            else { v2u w; w.x = cvt_pk_bf16(y0, y1); w.y = cvt_pk_bf16(y2, y3); *(v2u*)(op + 32 * db + 8 * g) = w; } }
#undef AT_KL
#undef AT_VL
}

__device__ __forceinline__ void attn_unit8(const unsigned char* Qp, const unsigned char* Kp, const unsigned char* VTp, int vpitch, int NT, int cw, bool rev, const bf16* GOp, bf16* OCp, LAS unsigned char* lds, int tid_in) {
    int tid = tid_in; asm volatile("" : "+v"(tid));
    constexpr int KP = 208, VP = 80, VOFF = 64 * KP, BUF = VOFF + 128 * VP;
    static_assert(2 * BUF <= RING_BYTES, "attention LDS image");
    const int lane = tid & 63, wave = __builtin_amdgcn_readfirstlane(tid >> 6), r32 = lane & 31, hi = lane >> 5;
    typedef int i32x4_ __attribute__((ext_vector_type(4))); typedef int i32x8_ __attribute__((ext_vector_type(8)));
#define AT8_LD(p_) __builtin_shufflevector(*(const LAS i32x4_*)(p_), *(const LAS i32x4_*)((p_) + 16), 0, 1, 2, 3, 4, 5, 6, 7)
    i32x8_ qf[3];
#pragma unroll
    for (int kk = 0; kk < 3; ++kk) { const i32x4_* qp = (const i32x4_*)(Qp + (size_t)(wave * 32 + r32) * 192 + 64 * kk + 32 * hi); qf[kk] = __builtin_shufflevector(qp[0], qp[1], 0, 1, 2, 3, 4, 5, 6, 7); }
    f32x16 o[4];
#pragma unroll
    for (int db = 0; db < 4; ++db)
#pragma unroll
        for (int r = 0; r < 16; ++r) o[db][r] = 0.f;
    float off = 0.f, l_run = 0.f;
    const unsigned ko = 16u * (unsigned)tid, vo = 16u * (unsigned)tid;
#define AT8_KL(c_) (((c_) / 12) * KP + ((c_) % 12) * 16)
#define AT8_VL(t_) (VOFF + ((t_) >> 2) * VP + ((t_) & 3) * 16)
    const int kfo = r32 * KP + 32 * hi, vfo = VOFF + r32 * VP + 32 * hi;
    const int kl0 = AT8_KL(tid), kl1 = AT8_KL(tid + 512), vl0 = AT8_VL(tid); const bool two = tid < 256;
    v4u sk0, sk1 = {0u, 0u, 0u, 0u}, sv;
    { const int tt0 = rev ? NT - 1 : 0; const unsigned char* kt = Kp + (size_t)tt0 * 12288; const unsigned char* vt = VTp + (size_t)tt0 * 8192;
      sk0 = *(const v4u*)(kt + ko); if (two) sk1 = *(const v4u*)(kt + 8192 + ko); sv = *(const v4u*)(vt + vo); }
    *(LAS v4u*)(lds + kl0) = sk0; if (two) *(LAS v4u*)(lds + kl1) = sk1; *(LAS v4u*)(lds + vl0) = sv;
    __syncthreads();
    for (int t = 0; t < NT; ++t) {
        const bool more = (t + 1 < NT);
        const int tt = rev ? NT - 1 - t : t;
        if (more) { const int tn = rev ? tt - 1 : tt + 1;
            const unsigned char* kt = Kp + (size_t)tn * 12288; const unsigned char* vt = VTp + (size_t)tn * 8192;
            sk0 = *(const v4u*)(kt + ko); if (two) sk1 = *(const v4u*)(kt + 8192 + ko); sv = *(const v4u*)(vt + vo); }
        if (tt <= cw) {
            LAS unsigned char* buf = lds + (t & 1) * BUF;
            f32x16 s0, s1;
#pragma unroll
            for (int r = 0; r < 16; ++r) { s0[r] = 0.f; s1[r] = 0.f; }
#define AT8_KFRAG(i) AT8_LD(buf + kfo + ((i) & 1) * 32 * KP + 64 * ((i) >> 1))
#define AT8_VFRAG(i) AT8_LD(buf + vfo + 32 * (i) * VP)
            i32x8_ ring[3];
            ring[0] = AT8_KFRAG(0); ring[1] = AT8_KFRAG(1);
            __builtin_amdgcn_sched_barrier(0);
#pragma unroll
            for (int i = 0; i < 6; ++i) {
                if (i + 2 < 6) ring[(i + 2) % 3] = AT8_KFRAG(i + 2);
                if (i & 1) s1 = __builtin_amdgcn_mfma_scale_f32_32x32x64_f8f6f4(ring[i % 3], qf[i >> 1], s1, 0, 0, 0, 0, 0, 0); else s0 = __builtin_amdgcn_mfma_scale_f32_32x32x64_f8f6f4(ring[i % 3], qf[i >> 1], s0, 0, 0, 0, 0, 0, 0);
                __builtin_amdgcn_sched_barrier(0);
            }
            ring[0] = AT8_VFRAG(0); ring[1] = AT8_VFRAG(1);
            if (__any(off != 0.f)) {
#pragma unroll
                for (int r = 0; r < 16; ++r) { s0[r] += off; s1[r] += off; } }
            float mx;
            asm("v_max3_f32 %0, %1, %2, %3" : "=v"(mx) : "v"(s0[0]), "v"(s0[1]), "v"(s0[2]));
#pragma unroll
            for (int r = 3; r < 15; r += 2) asm("v_max3_f32 %0, %0, %1, %2" : "+v"(mx) : "v"(s0[r]), "v"(s0[r + 1]));
            asm("v_max3_f32 %0, %0, %1, %2" : "+v"(mx) : "v"(s0[15]), "v"(s1[0]));
#pragma unroll
            for (int r = 1; r < 15; r += 2) asm("v_max3_f32 %0, %0, %1, %2" : "+v"(mx) : "v"(s1[r]), "v"(s1[r + 1]));
            { const float mo = shflx(mx, 32); asm("v_max3_f32 %0, %0, %1, %2" : "+v"(mx) : "v"(s1[15]), "v"(mo)); }
            if (__any(mx > 8.0f || mx < -2.0f)) {
                const float d = (mx > 8.0f || mx < -2.0f) ? mx - 4.0f : 0.f, alpha = __builtin_amdgcn_exp2f(-d);
                off -= d; l_run *= alpha;
#pragma unroll
                for (int r = 0; r < 16; ++r) { s0[r] -= d; s1[r] -= d; }
#pragma unroll
                for (int db = 0; db < 4; ++db)
#pragma unroll
                    for (int r = 0; r < 16; ++r) o[db][r] *= alpha;
            }
            float ps = 0.f;
#pragma unroll
            for (int r = 0; r < 16; ++r) { s0[r] = __builtin_amdgcn_exp2f(s0[r]); s1[r] = __builtin_amdgcn_exp2f(s1[r]); ps += s0[r] + s1[r]; }
            l_run += ps;
            i32x8_ pf;
#pragma unroll
            for (int j = 0; j < 8; ++j) { const f32x16& sx = (j < 4) ? s0 : s1; const int b = 4 * (j & 3); pf[j] = (int)pk_fp8x4(sx[b + 0], sx[b + 1], sx[b + 2], sx[b + 3]); }
            __builtin_amdgcn_sched_barrier(0);
#pragma unroll
            for (int i = 0; i < 4; ++i) {
                if (i + 2 < 4) ring[(i + 2) % 3] = AT8_VFRAG(i + 2);
                o[i] = __builtin_amdgcn_mfma_scale_f32_32x32x64_f8f6f4(ring[i % 3], pf, o[i], 0, 0, 0, 0, 0, 0);
                __builtin_amdgcn_sched_barrier(0);
            }
#undef AT8_KFRAG
#undef AT8_VFRAG
        }
        if (more) {
            LAS unsigned char* nb = lds + ((t + 1) & 1) * BUF;
            *(LAS v4u*)(nb + kl0) = sk0; if (two) *(LAS v4u*)(nb + kl1) = sk1; *(LAS v4u*)(nb + vl0) = sv;
        }
        __syncthreads();
    }
    const float inv = 16.0f / (l_run + shflx(l_run, 32));
    const bf16* gp = GOp + (size_t)(wave * 32 + r32) * 4096 + 4 * hi;
#pragma unroll
    for (int db = 0; db < 4; ++db)
#pragma unroll
        for (int g = 0; g < 4; ++g) { const bf16* p = gp + 32 * db + 8 * g; const v2u gv = *(const v2u*)p;
            float c0 = o[db][4 * g + 0] * inv * bf_lo(gv.x), c1 = o[db][4 * g + 1] * inv * bf_hi(gv.x), c2 = o[db][4 * g + 2] * inv * bf_lo(gv.y), c3 = o[db][4 * g + 3] * inv * bf_hi(gv.y);
            asm("v_min_f32 %0, 0x43e00000, %0\n\tv_max_f32 %0, 0xc3e00000, %0\n\tv_min_f32 %1, 0x43e00000, %1\n\tv_max_f32 %1, 0xc3e00000, %1\n\tv_min_f32 %2, 0x43e00000, %2\n\tv_max_f32 %2, 0xc3e00000, %2\n\tv_min_f32 %3, 0x43e00000, %3\n\tv_max_f32 %3, 0xc3e00000, %3" : "+v"(c0), "+v"(c1), "+v"(c2), "+v"(c3));
            *(unsigned*)((unsigned char*)OCp + (size_t)(wave * 32 + r32) * 8192 + 4 * hi + 32 * db + 8 * g) = pk_fp8x4(c0, c1, c2, c3); }
#undef AT8_KL
#undef AT8_VL
#undef AT8_LD
}

__device__ __forceinline__ void sb_wave(const bf16* QKV, const bf16* KFbh, const bf16* VFbh, size_t rowbase, int h, int q0, const bf16* GO, bf16* OC, int lane) {
    const int r32 = lane & 31, hi = lane >> 5;
    bf16x8 qf[8];
    const bf16* qp = QKV + (rowbase + q0 + r32) * 3072 + h * 128 + 8 * hi;
#pragma unroll
    for (int kk = 0; kk < 8; ++kk) qf[kk] = *(const bf16x8*)(qp + 16 * kk);
    f32x16 o[4];
#pragma unroll
    for (int db = 0; db < 4; ++db)
#pragma unroll
        for (int r = 0; r < 16; ++r) o[db][r] = 0.f;
    float R = 0.f;
    const int tq = q0 + r32;
    const float scale = 0.08838834764831845f;
    const float LN2 = 0.6931471805599453f;
    for (int key0 = q0; key0 >= 0; key0 -= 32) {
        f32x16 s;
#pragma unroll
        for (int r = 0; r < 16; ++r) s[r] = 0.f;
        const bf16* kp = KFbh + ((size_t)(key0 >> 5) * 8 * 64 + lane) * 8;
#pragma unroll
        for (int kk = 0; kk < 8; ++kk) { const bf16x8 a = *(const bf16x8*)(kp + kk * 512); s = __builtin_amdgcn_mfma_f32_32x32x16_bf16(a, qf[kk], s, 0, 0, 0); }
        float lf[16], lb[16]; float T0 = 0.f, T1 = 0.f;
#pragma unroll
        for (int r = 0; r < 16; ++r) { const int key = key0 + 16 * (r >> 3) + 8 * hi + (r & 7); const bool valid = key < tq;
            const float z = s[r] * scale; const float sp = __builtin_amdgcn_logf(1.0f + __builtin_amdgcn_exp2f(-fabsf(z) * LOG2E)) * LN2;
            lb[r] = valid ? (fminf(z, 0.f) - sp) : -INFINITY;
            lf[r] = valid ? (-fmaxf(z, 0.f) - sp) : 0.f;
            if (r < 8) T0 += lf[r]; else T1 += lf[r]; }
        const float PT0 = shflx(T0, 32), PT1 = shflx(T1, 32);
        float a0 = R + (hi == 0 ? (PT0 + T1 + PT1) : (PT1 + T1));
        float a1 = R + (hi == 0 ? PT1 : 0.f);
        float w[16];
#pragma unroll
        for (int r = 7; r >= 0; --r) { w[r] = __builtin_amdgcn_exp2f((lb[r] + a0) * LOG2E); a0 += lf[r]; }
#pragma unroll
        for (int r = 15; r >= 8; --r) { w[r] = __builtin_amdgcn_exp2f((lb[r] + a1) * LOG2E); a1 += lf[r]; }
        const float own = T0 + T1; R += own + shflx(own, 32);
        bf16x8 pf[2];
#pragma unroll
        for (int ks = 0; ks < 2; ++ks) { const int b = ks * 8; v4u pw; pw.x = cvt_pk_bf16(w[b + 0], w[b + 1]); pw.y = cvt_pk_bf16(w[b + 2], w[b + 3]); pw.z = cvt_pk_bf16(w[b + 4], w[b + 5]); pw.w = cvt_pk_bf16(w[b + 6], w[b + 7]); pf[ks] = __builtin_bit_cast(bf16x8, pw); }
        const bf16* vp = VFbh + ((size_t)(key0 >> 5) * 8 * 64 + lane) * 8;
#pragma unroll
        for (int db = 0; db < 4; ++db)
#pragma unroll
            for (int ks = 0; ks < 2; ++ks) { const bf16x8 vf = *(const bf16x8*)(vp + (db * 2 + ks) * 512); o[db] = __builtin_amdgcn_mfma_f32_32x32x16_bf16(vf, pf[ks], o[db], 0, 0, 0); }
        if (__all(R < -104.0f)) break;
    }
    const bf16* gp = GO + (rowbase + q0 + r32) * 4096 + 2048 + h * 128 + 4 * hi; bf16* op = OC + (rowbase + q0 + r32) * 4096 + 2048 + h * 128 + 4 * hi;
#pragma unroll
    for (int db = 0; db < 4; ++db)
#pragma unroll
        for (int g = 0; g < 4; ++g) { const bf16* p = gp + 32 * db + 8 * g; const v2u gv = *(const v2u*)p; v2u ww;
            ww.x = cvt_pk_bf16(o[db][4 * g + 0] * bf_lo(gv.x), o[db][4 * g + 1] * bf_hi(gv.x)); ww.y = cvt_pk_bf16(o[db][4 * g + 2] * bf_lo(gv.y), o[db][4 * g + 3] * bf_hi(gv.y));
            *(v2u*)(op + 32 * db + 8 * g) = ww; }
}

struct Args { const float* in[19]; float* out; unsigned char* ws; int s_lo, s_hi; };
enum { I_X = 0, I_MEM, I_POS, I_GPRE, I_WIN, I_GQLAT, I_WUQ, I_GKVLAT, I_WUKV, I_GQNA, I_GKNA, I_WPA, I_WPB, I_GMEM, I_WMKV, I_GQNM, I_GKNM, I_WPM, I_WOUT };
constexpr int NSTEPS = 3 + 8 * DEPTH;

__global__ void __launch_bounds__(NTHREADS, 2) fwd_kernel(Args args) {
    extern __shared__ __attribute__((aligned(16))) unsigned char lds_raw[];
    LAS unsigned char* lds = (LAS unsigned char*)lds_raw;
    volatile LAS unsigned* MISC = (volatile LAS unsigned*)(lds + MISC_OFF);
    const int tid0 = threadIdx.x, lane0 = tid0 & 63, wave = __builtin_amdgcn_readfirstlane(tid0 >> 6);
#define PHASE_LANE int tid = (wave << 6) | fresh_lane(); asm volatile("" : "+v"(tid));     const int lane = tid & 63; (void)lane; unsigned char* ws = ws_g; int bx = bx_g; asm volatile("" : "+s"(ws), "+s"(bx));
    const int G = gridDim.x; const int bx_g = blockIdx.x; const int vcu = (G % 8 == 0) ? (bx_g % 8) * (G / 8) + bx_g / 8 : bx_g;
    const int gw = vcu * NWAVES + wave, NGW = G * NWAVES;
    unsigned char* const ws_g = args.ws; unsigned char* ws = ws_g;
    for (int u = tid0; u < (LDS_BYTES - RING_BYTES) / 4; u += NTHREADS) ((LAS unsigned*)(lds + RING_BYTES))[u] = 0u;
    __syncthreads();
    XcdBarrier bar = xcd_barrier_post((unsigned*)(ws + WS_CTL) + CW_BAR, MISC + 8, wave);
    const int lo = args.s_lo, hi_ = args.s_hi;
#ifndef STEP_MASK
#define STEP_MASK 0x7ff
#endif
#define EN(b) (((STEP_MASK) >> (b)) & 1)
#ifndef REP_STEP
#define REP_STEP (-1)
#define REP_COUNT 1
#endif
#define REPS(k) ((k) == REP_STEP ? REP_COUNT : 1)
#define IN(k) (lo <= (k) && (k) < hi_)
#define SEAM(k) do { if ((k) + 1 < hi_) xcd_barrier(bar); } while (0)

    const float* x_in = args.in[I_X];
    float* out = args.out;
#define Hb ((bf16*)(ws + WS_H))
#define CQ ((bf16*)(ws + WS_CQ))
#define CKV ((bf16*)(ws + WS_CKV))
#define KR ((bf16*)(ws + WS_KR))
#define GO ((bf16*)(ws + WS_GO))
#define QKVB ((bf16*)(ws + WS_QKVB))
#define QM ((bf16*)(ws + WS_QM))
#define Rg ((bf16*)(ws + WS_R))
#define QAR ((bf16*)(ws + WS_QAR))
#define KVA ((bf16*)(ws + WS_KVA))
#define QA ((bf16*)(ws + WS_QA))
#define KA ((bf16*)(ws + WS_KA))
#define VTA ((bf16*)(ws + WS_VTA))
#define VTB ((bf16*)(ws + WS_VTB))
#define KFB ((bf16*)(ws + WS_KA + (size_t)M * 3072))
#define QMN ((bf16*)(ws + WS_QMN))
#define OC ((bf16*)(ws + WS_OC))
#define XA ((float*)(ws + WS_XA))
#define H8 ((unsigned char*)(ws + WS_H8))
#define MIXB ((bf16*)(ws + WS_MIXB))
#define MEMN ((bf16*)(ws + WS_MEMN))
#define KVM ((bf16*)(ws + WS_KVM))
#define KM ((bf16*)(ws + WS_KM))
#define VTM ((bf16*)(ws + WS_VTM))
#define ROPC ((float*)(ws + WS_ROPE))
#define ROPS (ROPC + (size_t)M * 32)
#define SSQX ((pg8::ssq_t*)(ws + WS_CTL + CTL_SSQX))
#define SSQQ ((pg8::ssq_t*)(ws + WS_CTL + CTL_SSQQ))
#define SSQK ((pg8::ssq_t*)(ws + WS_CTL + CTL_SSQK))
    if (EN(0) && IN(0)) { PHASE_LANE for (int rep_ = 0; rep_ < REPS(0); ++rep_) {
        LAS float* scr = (LAS float*)(lds + wave * 16384);
        constexpr int IT_IN = 64 * (NIN / 32), IT_UQ = 16 * 96, IT_UKV = 8 * 128, IT_PA = 32 * 128, IT_PB = 16 * 128, IT_PM = 16 * 128, IT_MKV = 64 * 64, IT_OUT = 64 * 128;
        constexpr int IT_LAYER = IT_IN + IT_UQ + IT_UKV + IT_PA + IT_PB + IT_PM + IT_MKV + IT_OUT;
#define TR_DECODE(it_, D) do { const int l = (it_) / IT_LAYER; int r = (it_) % IT_LAYER; unsigned char* wl_ = ws + WS_W + (size_t)l * WL_STRIDE; \
            if (r < IT_IN) { const int nb = NIN / 32, kb = r / nb, n0 = 32 * (r % nb); \
                if (n0 >= 9792 || n0 < 3648) D = TrDesc{args.in[I_WIN] + (size_t)l * 4096 * NIN, args.in[I_GPRE] + l * 4096, (bf16*)(wl_ + WL_W8), (n0 >= 9792) ? (size_t)(n0 - 9792) : (n0 < 1536 ? (size_t)(12288 + n0) : (n0 < 1600 ? (size_t)(15872 + n0 - 1536) : (size_t)(13824 + n0 - 1600))), NIN, 64 * kb, n0, 4096, 0, 1}; \
                else D = TrDesc{args.in[I_WIN] + (size_t)l * 4096 * NIN, args.in[I_GPRE] + l * 4096, (bf16*)(wl_ + WL_WIN), (size_t)(n0 - 3648), NIN, 64 * kb, n0, 4096, 0, 0}; break; } r -= IT_IN; \
            if (r < IT_UQ) { const int nb = 96, kb = r / nb, n0 = 32 * (r % nb); D = TrDesc{args.in[I_WUQ] + (size_t)l * 1024 * 3072, args.in[I_GQLAT] + l * 1024, (bf16*)(wl_ + WL_WUQ), (size_t)n0, 3072, 64 * kb, n0, 1024, 0, 0}; break; } r -= IT_UQ; \
            if (r < IT_UKV) { const int nb = 128, kb = r / nb, n0 = 32 * (r % nb); D = TrDesc{args.in[I_WUKV] + (size_t)l * 512 * 4096, args.in[I_GKVLAT] + l * 512, (bf16*)(wl_ + WL_WUKV), (size_t)n0, 4096, 64 * kb, n0, 512, 0, 0}; break; } r -= IT_UKV; \
            if (r < IT_PA) { const int nb = 128, kb = r / nb, n0 = 32 * (r % nb); D = TrDesc{args.in[I_WPA] + (size_t)l * 2048 * 4096, nullptr, (bf16*)(wl_ + WL_WPROJ), (size_t)n0, 4096, 64 * kb, n0, 8192, 0, 1}; break; } r -= IT_PA; \
            if (r < IT_PB) { const int nb = 128, kb = r / nb, n0 = 32 * (r % nb); D = TrDesc{args.in[I_WPB] + (size_t)l * 1024 * 4096, nullptr, (bf16*)(wl_ + WL_WPROJ), (size_t)n0, 4096, 64 * kb, n0, 4096, 2048, 0}; break; } r -= IT_PB; \
            if (r < IT_PM) { const int nb = 128, kb = r / nb, n0 = 32 * (r % nb); D = TrDesc{args.in[I_WPM] + (size_t)l * 1024 * 4096, nullptr, (bf16*)(wl_ + WL_WPROJ), (size_t)n0, 4096, 64 * kb, n0, 4096, 3072, 0}; break; } r -= IT_PM; \
            if (r < IT_MKV) { const int nb = 64, kb = r / nb, n0 = 32 * (r % nb); D = TrDesc{args.in[I_WMKV] + (size_t)l * 4096 * 2048, args.in[I_GMEM] + l * 4096, (bf16*)(ws + WS_WMKV), (size_t)(l * 2048 + n0), 2048, 64 * kb, n0, 4096, 0, 0}; break; } r -= IT_MKV; \
            { const int nb = 128, kb = r / nb, n0 = 32 * (r % nb); D = TrDesc{args.in[I_WOUT] + (size_t)l * 4096 * 4096, nullptr, (bf16*)(wl_ + WL_WOUT), (size_t)n0, 4096, 64 * kb, n0, 4096, 0, 0}; } } while (0)
        if (gw < DEPTH * IT_LAYER) {
            TrDesc cur{}; f32x4 vc[8]; TR_DECODE(gw, cur); tr_load(cur, vc, lane);
            for (int it = gw; it < DEPTH * IT_LAYER; it += NGW) {
                TrDesc nx = cur; f32x4 vn[8]; const bool more = it + NGW < DEPTH * IT_LAYER;
                if (more) { TR_DECODE(it + NGW, nx); tr_load(nx, vn, lane); }
                tr_finish(cur, vc, scr, lane);
                if (more) { cur = nx;
#pragma unroll
                    for (int i = 0; i < 8; ++i) vc[i] = vn[i]; }
            }
        }
#undef TR_DECODE
        for (int it = gw; it < DEPTH * 192 * 4; it += NGW) { const int l = it / (192 * 4), rr = (it / 4) % 192, seg = it % 4;
            *(v4u*)(ws + WS_W + (size_t)l * WL_STRIDE + WL_W8 + (size_t)(15936 + rr) * 4096 + seg * 1024 + lane * 16) = (v4u){0u, 0u, 0u, 0u}; }
        for (int row = gw; row < BATCH * MEMLEN; row += NGW) {
            const f32x4* xr = (const f32x4*)(args.in[I_MEM] + (size_t)row * 4096) + lane; f32x4 v[16]; float s = 0.f;
#pragma unroll
            for (int j = 0; j < 16; ++j) { v[j] = xr[64 * j]; s += (v[j].x * v[j].x + v[j].y * v[j].y) + (v[j].z * v[j].z + v[j].w * v[j].w); }
            const float rstd = 1.0f / sqrtf(wave_sum(s) * (1.0f / 4096.0f) + EPS);
            v2u* o8 = (v2u*)(MEMN + (size_t)row * 4096) + lane;
#pragma unroll
            for (int j = 0; j < 16; ++j) { v2u w; w.x = cvt_pk_bf16(v[j].x * rstd, v[j].y * rstd); w.y = cvt_pk_bf16(v[j].z * rstd, v[j].w * rstd); o8[64 * j] = w; }
        }
        for (int row = gw; row < M; row += NGW) {
            const f32x4* xr = (const f32x4*)(x_in + (size_t)row * 4096) + lane; f32x4 v[16]; float sq = 0.f;
#pragma unroll
            for (int j = 0; j < 16; ++j) { v[j] = xr[64 * j]; sq += (v[j].x * v[j].x + v[j].y * v[j].y) + (v[j].z * v[j].z + v[j].w * v[j].w); }
            sq = wave_sum(sq); if (lane == 0) SSQX[row] = (pg8::ssq_t)__float2ull_rn(sq * pg8::SSQ_FIX);
            v2u* o8 = (v2u*)(Hb + (size_t)row * 4096) + lane;
#pragma unroll
            for (int j = 0; j < 16; ++j) { v2u w; w.x = cvt_pk_bf16(v[j].x, v[j].y); w.y = cvt_pk_bf16(v[j].z, v[j].w); o8[64 * j] = w; }
            unsigned* o4 = (unsigned*)(H8 + (size_t)row * 4096) + lane;
#pragma unroll
            for (int j = 0; j < 16; ++j) { int p = __builtin_amdgcn_cvt_pk_fp8_f32(v[j].x, v[j].y, 0, false); p = __builtin_amdgcn_cvt_pk_fp8_f32(v[j].z, v[j].w, p, true); o4[64 * j] = (unsigned)p; }
        }
        for (int idx = blockIdx.x * NTHREADS + tid; idx < M * 32; idx += G * NTHREADS) { const int row = idx >> 5, j = idx & 31;
            const float freq = (float)exp2(-(double)j * (13.287712379549449 / 32.0));
            const float ang = (float)((const int*)args.in[I_POS])[row] * freq;
            const double a = (double)ang; ROPC[idx] = (float)cos(a); ROPS[idx] = (float)sin(a); }
        } SEAM(0);
    }

    if (EN(1) && IN(1)) { PHASE_LANE (void)tid; for (int rep_ = 0; rep_ < REPS(1); ++rep_) {
        pg8::Gemm g{MEMN, (const bf16*)(ws + WS_WMKV), BATCH * MEMLEN, DEPTH * 2048, 4096}; pg8::TailOrder S{G, bx};
        pg8::EpiPlain E{KVM, DEPTH * 2048, nullptr};
        pg8::gemm_phase<pg8::EpiPlain, pg8::TailOrder, true, true>(lds, g, S, E, tid);
        }
    }

    for (int l = 0; l < DEPTH; ++l) {
        const int sb = 3 + 8 * l;
        unsigned char* wl = ws + WS_W + (size_t)l * WL_STRIDE;
        const float* xcur = (l == 0) ? x_in : ((l & 1) ? (const float*)XA : (const float*)out); float* xnext = (l & 1) ? out : XA;

        if (EN(4) && IN(sb + 1)) { PHASE_LANE for (int rep_ = 0; rep_ < REPS(4); ++rep_) {
            pg8::Gemm g{Hb, (const bf16*)(wl + WL_WIN), M, NB16, 4096}; pg8::StaticOrder S; S.init(M, NB16, G, bx);
            LAS float* rst = (LAS float*)(lds + RSTAB_OFF);
            { pg8::Unit u0{0, 0}; (void)S.next(0, u0); int pm0 = u0.pm; asm volatile("" : "+s"(pm0)); if (tid < 256) rst[tid] = __builtin_amdgcn_rsqf(pg8::ssq_get(SSQX + (size_t)l * M + pm0 * 256 + tid) * (1.0f / 4096.0f) + EPS); }
            __syncthreads();
            pg8::EpiIn<WsL> E{ws, rst};
            pg8::gemm_phase<pg8::EpiIn<WsL>, pg8::StaticOrder, true, true>(lds, g, S, E, tid);
            { pg8::Gemm g8{(const bf16*)H8, (const bf16*)(wl + WL_W8), M, NG8, 2048}; pg8::StaticOrder S8; S8.init(M, NG8, G, bx);
              pg8::EpiGate<WsL> E8{ws, rst, l * M};
              pg8::gemm_phase<pg8::EpiGate<WsL>, pg8::StaticOrder, true, true>(lds, g8, S8, E8, tid); }
            } SEAM(sb + 1);
        }

        if (EN(6) && IN(sb + 3)) { PHASE_LANE for (int rep_ = 0; rep_ < REPS(6); ++rep_) {
            LAS float* rst = (LAS float*)(lds + RSTAB_OFF);
            { pg8::StaticOrder S0; S0.init(M, 4096, G, bx); pg8::Unit u0;
              if (S0.next(0, u0) && tid < 256) { rst[tid] = __builtin_amdgcn_rsqf(pg8::ssq_get(SSQQ + (size_t)l * M + u0.pm * 256 + tid) * (1.0f / 1024.0f) + EPS); rst[256 + tid] = __builtin_amdgcn_rsqf(pg8::ssq_get(SSQK + (size_t)l * M + u0.pm * 256 + tid) * (1.0f / 512.0f) + EPS); } }
            __syncthreads();
            for (int j = 0; j < 2; ++j) {
                pg8::Gemm g = (j == 0) ? pg8::Gemm{CQ, (const bf16*)(wl + WL_WUQ), M, 3072, 1024} : pg8::Gemm{CKV, (const bf16*)(wl + WL_WUKV), M, 4096, 512};
                pg8::StaticOrder S; S.init(M, g.N, G, bx);
                pg8::EpiPlain E{(j == 0) ? QAR : KVA, g.N, rst + 256 * j};
                pg8::gemm_phase<pg8::EpiPlain, pg8::StaticOrder, true, true>(lds, g, S, E, tid);
            }
            } SEAM(sb + 3);
        }

        if (EN(7) && IN(sb + 4)) { PHASE_LANE for (int rep_ = 0; rep_ < REPS(7); ++rep_) {
            LAS unsigned char* scr = lds + wave * 9216;
            const float* gqa = args.in[I_GQNA] + l * 192; const float* gka = args.in[I_GKNA] + l * 192; const float* gqm = args.in[I_GQNM] + l * 256;
            constexpr int N_A = 256 * 16, N_B = 256 * 16, N_C = 256 * 16 * 2, N_D = 256 * 8 * 2, N_E = 256 * 4, N_F = 2 * 4 * 4 * 5;
            const float QSC = 0.07216878364870322f * LOG2E;
            const float MSC = 0.0625f * LOG2E;
            for (int it = gw; it < N_A + N_B + N_C + N_D + N_E + N_F; it += NGW) {
                int r = it;
                if (r >= N_A + N_B + N_C + N_D + N_E) {
                    r -= N_A + N_B + N_C + N_D + N_E;
                    const int job = r % 5, kb = (r / 5) % 4, h = (r / 20) % 4, b = r / 80; const size_t lbh = ((size_t)l * 2 + b) * 4 + h;
                    if (job == 0) {
                        const bf16* src = KVM + (size_t)(b * 256 + kb * 64 + lane) * 8192 + l * 2048 + h * 256; float ss = 0.f;
#pragma unroll 4
                        for (int c = 0; c < 32; ++c) ss += ssq8(*(const v4u*)(src + 8 * c));
                        const float rstd = 1.0f / sqrtf(ss * (1.0f / 256.0f) + EPS);
                        const float* gk = args.in[I_GKNM] + l * 256; bf16* dst = KM + (lbh * 256 + kb * 64 + lane) * 256;
#pragma unroll 4
                        for (int c = 0; c < 32; ++c) { const v4u v = *(const v4u*)(src + 8 * c); v4u w;
#pragma unroll
                            for (int e = 0; e < 4; ++e) w[e] = cvt_pk_bf16(bf_lo(v[e]) * rstd * gk[8 * c + 2 * e], bf_hi(v[e]) * rstd * gk[8 * c + 2 * e + 1]);
                            *(v4u*)(dst + 8 * c) = w; }
                    } else { const int dq = job - 1;
                        transpose_64x64(KVM + (size_t)(b * 256 + kb * 64) * 8192 + l * 2048 + 1024 + h * 256 + dq * 64, 8192, VTM + (lbh * 256 + dq * 64) * 256 + kb * 64, 256, scr, lane); }
                    continue;
                }
                if (r < N_A + N_B) {
                    const bool isq = r < N_A; if (!isq) r -= N_A;
                    const int tb = r / 16, h = r % 16, p = lane & 7; const float* gv = isq ? gqa : gka;
                    float g0[8], g1[8], g2[8];
#pragma unroll
                    for (int e = 0; e < 8; ++e) { g0[e] = gv[8 * p + e]; g1[e] = gv[64 + 8 * p + e]; g2[e] = gv[128 + 8 * p + e]; }
                    for (int sub = 0; sub < 8; ++sub) {
                        const size_t row = (size_t)tb * 64 + sub * 8 + (lane >> 3); const int b = (int)(row / SEQ), s = (int)(row % SEQ);
                        const bf16* nope = isq ? QAR + row * 3072 + h * 192 : KVA + row * 4096 + h * 256;
                        const bf16* ropp = isq ? nope + 128 : KR + row * 64;
                        const v4u v0 = *(const v4u*)(nope + 8 * p), v1 = *(const v4u*)(nope + 64 + 8 * p), v2 = *(const v4u*)(ropp + 8 * p);
                        const f32x4 c0 = *(const f32x4*)(ROPC + row * 32 + 8 * (p & 3)), c1 = *(const f32x4*)(ROPC + row * 32 + 8 * (p & 3) + 4);
                        const f32x4 n0 = *(const f32x4*)(ROPS + row * 32 + 8 * (p & 3)), n1 = *(const f32x4*)(ROPS + row * 32 + 8 * (p & 3) + 4);
                        float ss = ssq8(v0) + ssq8(v1) + ssq8(v2);
                        ss += shflx(ss, 1); ss += shflx(ss, 2); ss += shflx(ss, 4);
                        const float sc = (1.0f / sqrtf(ss * (1.0f / 192.0f) + EPS)) * (isq ? 4.0f * QSC : 0.25f);
                        unsigned char* dst = (unsigned char*)(isq ? QA : KA) + (((size_t)b * 16 + h) * SEQ + s) * 192;
                        float f0[8], f1[8];
#pragma unroll
                        for (int e = 0; e < 4; ++e) { f0[2 * e] = bf_lo(v0[e]) * sc * g0[2 * e]; f0[2 * e + 1] = bf_hi(v0[e]) * sc * g0[2 * e + 1]; f1[2 * e] = bf_lo(v1[e]) * sc * g1[2 * e]; f1[2 * e + 1] = bf_hi(v1[e]) * sc * g1[2 * e + 1]; }
                        float xo[8], xp[8];
#pragma unroll
                        for (int e = 0; e < 4; ++e) { xo[2 * e] = bf_lo(v2[e]) * sc * g2[2 * e]; xo[2 * e + 1] = bf_hi(v2[e]) * sc * g2[2 * e + 1]; }
#pragma unroll
                        for (int e = 0; e < 8; ++e) xp[e] = shflx(xo[e], 4);
                        const float sgn = (p < 4) ? -1.0f : 1.0f; float ro[8];
#pragma unroll
                        for (int e = 0; e < 8; ++e) { const float c_ = (e < 4) ? c0[e] : c1[e - 4], s_ = (e < 4) ? n0[e] : n1[e - 4]; ro[e] = xo[e] * c_ + sgn * xp[e] * s_; }
                        *(v2u*)(dst + 8 * p) = (v2u){pk_fp8x4(f0[0], f0[1], f0[2], f0[3]), pk_fp8x4(f0[4], f0[5], f0[6], f0[7])};
                        *(v2u*)(dst + 64 + 8 * p) = (v2u){pk_fp8x4(f1[0], f1[1], f1[2], f1[3]), pk_fp8x4(f1[4], f1[5], f1[6], f1[7])};
                        *(v2u*)(dst + 128 + 8 * p) = (v2u){pk_fp8x4(ro[0], ro[1], ro[2], ro[3]), pk_fp8x4(ro[4], ro[5], ro[6], ro[7])};
                    }
                    continue;
                }
                r -= N_A + N_B;
                if (r < N_C) {
                    const int dh = r & 1, h = (r >> 1) % 16, tb = r / 32; const int b = (tb * 64) / SEQ, s0 = (tb * 64) % SEQ;
                    transpose_64x64_f8(KVA + (size_t)tb * 64 * 4096 + h * 256 + 128 + dh * 64, 4096, (unsigned char*)VTA + ((((size_t)b * 16 + h) * 128 + (s0 >> 6)) * 128 + dh * 64) * 64, 64, scr, lane); continue; }
                r -= N_C;
                if (r < N_D) {
                    const int dh = r & 1, h = (r >> 1) % 8, tb = r / 16; const int b = (tb * 64) / SEQ, s0 = (tb * 64) % SEQ;
                    transpose_64x64_frag(QKVB + (size_t)tb * 64 * 3072 + 2048 + h * 128 + dh * 64, 3072, VTB + ((size_t)b * 8 + h) * 128 * SEQ, s0 >> 5, dh, scr, lane); continue; }
                r -= N_D;
                {
                    const int tb = r / 4, h = r % 4, p = lane & 7;
                    float g[4][8];
#pragma unroll
                    for (int k = 0; k < 4; ++k)
#pragma unroll
                        for (int e = 0; e < 8; ++e) g[k][e] = gqm[64 * k + 8 * p + e];
                    for (int sub = 0; sub < 8; ++sub) {
                        const size_t row = (size_t)tb * 64 + sub * 8 + (lane >> 3); const int b = (int)(row / SEQ), s = (int)(row % SEQ);
                        const bf16* src = QM + row * 1024 + h * 256 + 8 * p; v4u v[4]; float ss = 0.f;
#pragma unroll
                        for (int k = 0; k < 4; ++k) { v[k] = *(const v4u*)(src + 64 * k); ss += ssq8(v[k]); }
                        ss += shflx(ss, 1); ss += shflx(ss, 2); ss += shflx(ss, 4);
                        const float sc = (1.0f / sqrtf(ss * (1.0f / 256.0f) + EPS)) * MSC;
                        bf16* dst = QMN + (((size_t)b * 4 + h) * SEQ + s) * 256 + 8 * p;
#pragma unroll
                        for (int k = 0; k < 4; ++k) { v4u w;
#pragma unroll
                            for (int e = 0; e < 4; ++e) w[e] = cvt_pk_bf16(bf_lo(v[k][e]) * sc * g[k][2 * e], bf_hi(v[k][e]) * sc * g[k][2 * e + 1]);
                            *(v4u*)(dst + 64 * k) = w; }
                    }
                }
            }
            } SEAM(sb + 4);
        }

        if (EN(8) && IN(sb + 5)) { PHASE_LANE for (int rep_ = 0; rep_ < REPS(8); ++rep_) {
            bool fixM;
            { float c = 0.f, d = 0.f;
              for (int i = 0; i < 256; ++i) { c = fmaxf(c, fabsf(args.in[I_GQNM][l * 256 + i])); d = fmaxf(d, fabsf(args.in[I_GKNM][l * 256 + i])); }
              fixM = 16.0f * LOG2E * 1.05f * c * d <= 96.0f; }
            for (int ua = vcu; ua < BATCH * 16 * 8; ua += G) { const int bh = ua >> 3, s = ua & 7, b = bh >> 4, h = bh & 15;
                for (int i = 0; i < 4; ++i) { const int qb = (i == 0) ? s : (i == 1) ? 15 - s : (i == 2) ? 16 + s : 31 - s; const size_t go = ((size_t)b * SEQ + qb * 256) * 4096 + h * 128;
                    bf16* const oc8 = (bf16*)((unsigned char*)OC + ((size_t)b * SEQ + qb * 256) * 8192 + h * 128);
                    attn_unit8((const unsigned char*)QA + ((size_t)bh * SEQ + qb * 256) * 192, (const unsigned char*)KA + (size_t)bh * SEQ * 192, (const unsigned char*)VTA + (size_t)bh * 128 * SEQ, SEQ, 4 * qb + 4, 4 * qb + (wave >> 1), (i & 1) != 0, GO + go, oc8, lds, tid); } }
            int tidm = tid; asm volatile("" : "+v"(tidm));
            for (int um = vcu; um < BATCH * 4 * 32; um += G) { const int bh = um >> 5, qb = um & 31, b = bh >> 2, h = bh & 3; const size_t lbh = ((size_t)l * 2 + b) * 4 + h;
                if (fixM) {
                    for (int pass = 0; pass < 2; ++pass) { const size_t go = ((size_t)b * SEQ + qb * 256) * 4096 + 3072 + h * 256 + pass * 128;
                        attn_unit<256, 4, true>(QMN + ((size_t)bh * SEQ + qb * 256) * 256, KM + lbh * 256 * 256, VTM + (lbh * 256 + pass * 128) * 256, 256, 4, 4, false, GO + go, OC + go, lds, tidm); }
                } else {
                    for (int pass = 0; pass < 4; ++pass) { const size_t go = ((size_t)b * SEQ + qb * 256) * 4096 + 3072 + h * 256 + pass * 64;
                        attn_unit<256, 2, false>(QMN + ((size_t)bh * SEQ + qb * 256) * 256, KM + lbh * 256 * 256, VTM + (lbh * 256 + pass * 64) * 256, 256, 4, 4, false, GO + go, OC + go, lds, tidm); }
                } }
            for (int u = gw; u < BATCH * 8 * 256; u += NGW) { const int bh = u >> 8, qb = u & 255; const int b = bh >> 3, h = bh & 7;
                sb_wave(QKVB, KFB + (size_t)bh * 128 * SEQ, VTB + (size_t)bh * 128 * SEQ, (size_t)b * SEQ, h, 32 * qb, GO, OC, lane); }
            } SEAM(sb + 5);
        }

        if (EN(9) && IN(sb + 6)) { PHASE_LANE for (int rep_ = 0; rep_ < REPS(9); ++rep_) {
            pg8::Gemm g{OC, (const bf16*)(wl + WL_WPROJ), M, 4096, 48 * 64, 4096}; pg8::StaticOrder S; S.init(M, 4096, G, bx);
            pg8::EpiProj E{Rg, MIXB};
            pg8::gemm_phase<pg8::EpiProj, pg8::StaticOrder, true, true>(lds, g, S, E, tid);
            } SEAM(sb + 6);
        }

        if (EN(10) && IN(sb + 7)) { PHASE_LANE for (int rep_ = 0; rep_ < REPS(10); ++rep_) {
            pg8::Gemm g{MIXB, (const bf16*)(wl + WL_WOUT), M, 4096, 4096}; pg8::StaticOrder S; S.init(M, 4096, G, bx);
            pg8::EpiOut E{xcur, xnext, (l + 1 < DEPTH) ? Hb : nullptr, H8, SSQX + (size_t)((l + 1 < DEPTH) ? l + 1 : 0) * M};
            pg8::gemm_phase<pg8::EpiOut, pg8::StaticOrder, true, true>(lds, g, S, E, tid);
            } SEAM(sb + 7);
        }
    }
#undef IN
#undef SEAM
#undef Hb
#undef CQ
#undef CKV
#undef KR
#undef GO
#undef QKVB
#undef QM
#undef Rg
#undef QAR
#undef KVA
#undef QA
#undef KA
#undef VTA
#undef VTB
#undef KFB
#undef QMN
#undef OC
#undef XA
#undef H8
#undef MIXB
#undef MEMN
#undef KVM
#undef KM
#undef VTM
#undef ROPC
#undef ROPS
#undef SSQX
#undef SSQQ
#undef SSQK
}

#ifndef MK_LAUNCH_PER_STEP
#define MK_LAUNCH_PER_STEP 0
#endif
extern "C" void kernel_launch(void* const* d_in, const int* in_sizes, int n_in, void* d_out, int out_size, void* d_ws, size_t ws_size, hipStream_t stream) {
    static int grid = 0;
    if (grid == 0) {
        if (n_in != 19 || out_size != M * DM || ws_size < WS_END) { fprintf(stderr, "kernel_launch: unexpected problem (n_in %d, out %d, ws %zu < %zu)\n", n_in, out_size, ws_size, (size_t)WS_END); grid = -1; return; }
        int dev = 0, cus = 0, per_cu = 0;
        if (hipGetDevice(&dev) != hipSuccess || hipDeviceGetAttribute(&cus, hipDeviceAttributeMultiprocessorCount, dev) != hipSuccess) { grid = -1; return; }
        if (hipFuncSetAttribute((const void*)fwd_kernel, hipFuncAttributeMaxDynamicSharedMemorySize, LDS_BYTES) != hipSuccess) { fprintf(stderr, "kernel_launch: hipFuncSetAttribute failed\n"); grid = -1; return; }
        if (hipOccupancyMaxActiveBlocksPerMultiprocessor(&per_cu, (const void*)fwd_kernel, NTHREADS, LDS_BYTES) != hipSuccess || per_cu < 1) fprintf(stderr, "kernel_launch: occupancy query says %d\n", per_cu);
        (void)hipGetLastError();
        if (cus < 256) { fprintf(stderr, "kernel_launch: %d CUs, this kernel is laid out for 256 (MI355X)\n", cus); grid = -1; return; }
        grid = 256;
    }
    if (grid < 0) return;
    if (hipMemsetAsync((char*)d_ws + WS_CTL, 0, CTL_ZERO_BYTES, stream) != hipSuccess) return;
    Args a{};
    for (int i = 0; i < 19; ++i) a.in[i] = (const float*)d_in[i];
    a.out = (float*)d_out; a.ws = (unsigned char*)d_ws;
#if MK_LAUNCH_PER_STEP
    for (int s = 0; s < NSTEPS; ++s) { a.s_lo = s; a.s_hi = s + 1; hipLaunchKernelGGL(fwd_kernel, dim3(grid), dim3(NTHREADS), LDS_BYTES, stream, a); }
#else
    a.s_lo = 0; a.s_hi = NSTEPS;
    hipLaunchKernelGGL(fwd_kernel, dim3(grid), dim3(NTHREADS), LDS_BYTES, stream, a);
#endif
}
```

```cpp
#include <hip/hip_runtime.h>
#include <cstdio>
#include <cstdint>
__device__ __forceinline__ int fresh_lane() { int l; asm volatile("v_mbcnt_lo_u32_b32 %0, -1, 0\n\tv_mbcnt_hi_u32_b32 %0, -1, %0" : "=v"(l)); return l; }
__device__ __forceinline__ float shflx(float v, int m) { return __int_as_float(__builtin_amdgcn_ds_bpermute((fresh_lane() ^ m) << 2, __float_as_int(v))); }
namespace pg8 {
#define PG8_LAS __attribute__((address_space(3)))
typedef unsigned short bf16_t;
typedef short bf16x8 __attribute__((ext_vector_type(8)));
typedef float f32x4 __attribute__((ext_vector_type(4)));
typedef unsigned u32x4 __attribute__((ext_vector_type(4)));
typedef int i32x4 __attribute__((ext_vector_type(4)));
typedef int i32x8 __attribute__((ext_vector_type(8)));
constexpr int BM = 256, BK = 64, HALF = 128, HTB = HALF * BK * 2  , STAGE_BYTES = 8 * HTB, NXCD = 8, WGM = 8;

__host__ __device__ __forceinline__ int lds_byte(int r, int c) { const int st = (r >> 4) * 2 + (c >> 5), rr = r & 15, cc = c & 31, ob = rr * 64 + cc * 2; return st * 1024 + (ob ^ (((ob >> 9) & 1) << 5)); }
__host__ __device__ __forceinline__ void stage_rc(int b, int& R, int& C) { const int st = b / 1024, sb = b % 1024, swz = sb ^ (((sb >> 9) & 1) << 5); R = (st >> 1) * 16 + swz / 64; C = (st & 1) * 32 + (swz % 64) / 2; }
__host__ __device__ __forceinline__ int perm32(int rho) { const int n = rho >> 4, i = rho & 15; return 8 * (i >> 2) + 4 * n + (i & 3); }

struct Unit { int pm, pn; };
struct Gemm { const bf16_t* A; const bf16_t* Bt; int M, N, K; int ld = 0; };

struct StaticOrder {
    int nM, nN, nwg, G, c;
    __host__ __device__ void init(int M, int N, int G_, int c_) { nM = M / BM; nN = N / BM; nwg = nM * nN; G = G_; c = c_; }
    __host__ __device__ bool next(int i, Unit& u) const {
        const long L = (long)i * G + c; if (L >= nwg) return false;
        int wgid = (int)L; { const int q = nwg / NXCD, r = nwg % NXCD, xcd = wgid % NXCD, off = wgid / NXCD; wgid = (xcd < r ? xcd * (q + 1) : r * (q + 1) + (xcd - r) * q) + off; }
        const int nig = WGM * nN, gid = wgid / nig, fm = gid * WGM, gsz = (nM - fm) < WGM ? (nM - fm) : WGM;
        u.pm = fm + ((wgid % nig) % gsz); u.pn = (wgid % nig) / gsz; return true;
    }
    __device__ __forceinline__ void a_ready(const Unit&) const {}
    __device__ __forceinline__ void done(const Unit&) const {}
};


struct TailOrder {
    int G, c;
    __device__ bool next(int i, Unit& u) const {
        const int base = G > 64 ? G - 64 : 0; if (c < base) return false;
        const int L = (c - base) + i * (G - base); if (L >= 64) return false;
        u.pm = L & 1; u.pn = L >> 1; return true;
    }
    __device__ __forceinline__ void a_ready(const Unit&) const {}
    __device__ __forceinline__ void done(const Unit&) const {}
};

typedef float f32x2v __attribute__((ext_vector_type(2)));
typedef __bf16 bf16x2v __attribute__((ext_vector_type(2)));
__device__ __forceinline__ unsigned cvt_pk_bf16(float lo, float hi) { f32x2v v = {lo, hi}; bf16x2v b = __builtin_convertvector(v, bf16x2v); return __builtin_bit_cast(unsigned, b); }
__device__ __forceinline__ float bf_lo(unsigned w) { return __uint_as_float(w << 16); }
__device__ __forceinline__ float bf_hi(unsigned w) { return __uint_as_float(w & 0xffff0000u); }
constexpr float LOG2E = 1.4426950408889634f;
__device__ __forceinline__ float sigmoid_f(float v) { return __builtin_amdgcn_rcpf(1.0f + __builtin_amdgcn_exp2f(-v * LOG2E)); }

__device__ __forceinline__ void row_scales(float (&rs)[8], const PG8_LAS float* tab, int wr, int fr) {
#pragma unroll
    for (int i = 0; i < 8; ++i) rs[i] = tab[wr * 64 + (i >> 2) * HALF + (i & 3) * 16 + fr];
}

template <bool F8> struct EpiPlainT {
    static constexpr bool FP8 = F8; static constexpr int MIXT = 0;
    static constexpr bool PERM = true, AFTER_DRAIN = false, HOOK = false; static constexpr int HOOK_T0 = -1, HOOK_T1 = -1;
    bf16_t* O; int ldc; const PG8_LAS float* rstab;
    __device__ __forceinline__ void mid(f32x4 (&)[2][2][4][2], const Unit&, int, int, int, int, int) const {}
    __device__ __forceinline__ void operator()(const f32x4 (&acc)[2][2][4][2], const Unit& u, int wr, int wc, int fr, int fq) const {
        int fr_ = fr, fq_ = fq; asm volatile("" : "+v"(fr_), "+v"(fq_));
        const int row0 = u.pm * BM + wr * 64 + fr_, col0 = u.pn * BM + wc * 32 + 8 * fq_;
        float rsv[8];
        if (rstab) row_scales(rsv, rstab, wr, fr_); else {
#pragma unroll
            for (int i = 0; i < 8; ++i) rsv[i] = 1.0f; }
#pragma unroll
        for (int ai = 0; ai < 2; ++ai)
#pragma unroll
            for (int m = 0; m < 4; ++m) { bf16_t* rowp = O + (size_t)(row0 + ai * HALF + m * 16) * ldc + col0;
                const float rs = rsv[ai * 4 + m];
#pragma unroll
                for (int bj = 0; bj < 2; ++bj) { const f32x4 v0 = acc[ai][bj][m][0] * rs, v1 = acc[ai][bj][m][1] * rs;
                    u32x4 w; w.x = cvt_pk_bf16(v0[0], v0[1]); w.y = cvt_pk_bf16(v0[2], v0[3]); w.z = cvt_pk_bf16(v1[0], v1[1]); w.w = cvt_pk_bf16(v1[2], v1[3]);
                    *(u32x4*)(rowp + bj * HALF) = w; } }
    }
};

using EpiPlain = EpiPlainT<false>;

typedef unsigned long long ssq_t;
constexpr float SSQ_FIX = 16777216.0f, SSQ_UNFIX = 1.0f / 16777216.0f;
__device__ __forceinline__ void ssq_add(ssq_t* p, float sq) { atomicAdd(p, (ssq_t)__float2ull_rn(sq * SSQ_FIX)); }
__device__ __forceinline__ float ssq_get(const ssq_t* p) { return (float)(*p) * SSQ_UNFIX; }

template <int ACT, bool OUT8 = false> __device__ __forceinline__ void epi_tile(const f32x4 (&acc)[2][2][4][2], bf16_t* base, int ldc, int row0, int cl, bool kr, ssq_t* ssqo, int fq, const float (&rsv)[8]) {
    const __amdgpu_buffer_rsrc_t rsd = __builtin_amdgcn_make_buffer_rsrc((void*)base, 0, -1, 0x00020000);
    const int vo = (row0 * ldc + cl) * (OUT8 ? 1 : 2);
#pragma unroll
    for (int ai = 0; ai < 2; ++ai)
#pragma unroll
        for (int m = 0; m < 4; ++m) {
            const float rs = rsv[ai * 4 + m]; float sq = 0.f;
#pragma unroll
            for (int bj = 0; bj < 2; ++bj) { if (kr && bj == 1) continue;
                f32x4 v0 = acc[ai][bj][m][0] * rs, v1 = acc[ai][bj][m][1] * rs;
                if (ACT == 0) sq += (v0[0] * v0[0] + v0[1] * v0[1]) + (v0[2] * v0[2] + v0[3] * v0[3]) + (v1[0] * v1[0] + v1[1] * v1[1]) + (v1[2] * v1[2] + v1[3] * v1[3]);
                if (ACT != 0) {
#pragma unroll
                    for (int e = 0; e < 4; ++e) { v0[e] *= sigmoid_f(v0[e]); v1[e] *= sigmoid_f(v1[e]); } }
                if constexpr (OUT8) { int p0 = __builtin_amdgcn_cvt_pk_fp8_f32(v0[0], v0[1], 0, false); p0 = __builtin_amdgcn_cvt_pk_fp8_f32(v0[2], v0[3], p0, true);
                    int p1 = __builtin_amdgcn_cvt_pk_fp8_f32(v1[0], v1[1], 0, false); p1 = __builtin_amdgcn_cvt_pk_fp8_f32(v1[2], v1[3], p1, true);
                    typedef unsigned u32x2 __attribute__((ext_vector_type(2)));
                    __builtin_amdgcn_raw_buffer_store_b64((u32x2){(unsigned)p0, (unsigned)p1}, rsd, vo + (ai * HALF + m * 16) * ldc + bj * HALF, 0, 0); }
                else {
                u32x4 w; w.x = cvt_pk_bf16(v0[0], v0[1]); w.y = cvt_pk_bf16(v0[2], v0[3]); w.z = cvt_pk_bf16(v1[0], v1[1]); w.w = cvt_pk_bf16(v1[2], v1[3]);
                __builtin_amdgcn_raw_buffer_store_b128(w, rsd, vo + (ai * HALF + m * 16) * ldc * 2 + bj * (HALF * 2), 0, 0); } }
            if (ACT == 0 && ssqo) { sq += shflx(sq, 16); sq += shflx(sq, 32); if (fq == 0) ssq_add(ssqo + row0 + ai * HALF + m * 16, sq); } }
}

__device__ __forceinline__ int pi32e(int i) { return (i & ~12) | ((i & 4) << 1) | ((i & 8) >> 1); }
__device__ __forceinline__ void epi_tile_kfrag(const f32x4 (&acc)[2][2][4][2], bf16_t* kfb, int pm, int pnk, int wr, int wc, int fr, int fq, const float (&rsv)[8]) {
    const __amdgpu_buffer_rsrc_t rsd = __builtin_amdgcn_make_buffer_rsrc((void*)kfb, 0, -1, 0x00020000);
    const int b = pm >> 5, tile0 = (pm & 31) * 8 + wr * 2, kk = wc * 2 + (fq >> 1), hi = fq & 1;
    const int vo = ((((b * 8 + pnk * 2) * 256 + tile0) * 8 + kk) * 64 + hi * 32 + pi32e(fr)) * 16;
#pragma unroll
    for (int ai = 0; ai < 2; ++ai)
#pragma unroll
        for (int m = 0; m < 4; ++m) { const float rs = rsv[ai * 4 + m];
#pragma unroll
            for (int bj = 0; bj < 2; ++bj) { const f32x4 v0 = acc[ai][bj][m][0] * rs, v1 = acc[ai][bj][m][1] * rs;
                u32x4 w; w.x = cvt_pk_bf16(v0[0], v0[1]); w.y = cvt_pk_bf16(v0[2], v0[3]); w.z = cvt_pk_bf16(v1[0], v1[1]); w.w = cvt_pk_bf16(v1[2], v1[3]);
                __builtin_amdgcn_raw_buffer_store_b128(w, rsd, vo + ai * 32768 + (m >> 1) * 8192 + (m & 1) * 256 + bj * 2097152, 0, 0); } }
}

template <class L> struct EpiIn {
    static constexpr bool FP8 = false; static constexpr int MIXT = 0;
    static constexpr bool PERM = true, AFTER_DRAIN = false, HOOK = false; static constexpr int HOOK_T0 = -1, HOOK_T1 = -1;
    unsigned char* ws; const PG8_LAS float* rstab;
    __device__ __forceinline__ void mid(f32x4 (&)[2][2][4][2], const Unit&, int, int, int, int, int) const {}
    __device__ __forceinline__ void operator()(const f32x4 (&acc)[2][2][4][2], const Unit& u, int wr, int wc, int fr, int fq) const {
        int fr_ = fr, fq_ = fq; asm volatile("" : "+v"(fr_), "+v"(fq_));
        const int pn = u.pn, row0 = u.pm * BM + wr * 64 + fr_, cl = wc * 32 + 8 * fq_;
        float rsv[8]; row_scales(rsv, rstab, wr, fr_);
        bf16_t* const GO = (bf16_t*)(ws + L::GO); bf16_t* const QKVB = (bf16_t*)(ws + L::QKVB); bf16_t* const QM = (bf16_t*)(ws + L::QM);
        if (pn >= 4 && pn < 8) epi_tile_kfrag(acc, (bf16_t*)(ws + L::KFB), u.pm, pn - 4, wr, wc, fr_, fq_, rsv);
        else if (pn < 12) epi_tile<0>(acc, QKVB, 3072, row0, pn * 256 + cl, false, nullptr, fq_, rsv);
        else if (pn < 16) epi_tile<1>(acc, GO, 4096, row0, 2048 + (pn - 12) * 256 + cl, false, nullptr, fq_, rsv);
        else if (pn < 20) epi_tile<0>(acc, QM, 1024, row0, (pn - 16) * 256 + cl, false, nullptr, fq_, rsv);
        else              epi_tile<1>(acc, GO, 4096, row0, 3072 + (pn - 20) * 256 + cl, false, nullptr, fq_, rsv);
    }
};

template <class L> struct EpiGate {
    static constexpr bool FP8 = true; static constexpr int MIXT = 0;
    static constexpr bool PERM = true, AFTER_DRAIN = false, HOOK = false; static constexpr int HOOK_T0 = -1, HOOK_T1 = -1;
    unsigned char* ws; const PG8_LAS float* rstab; int lrow;
    __device__ __forceinline__ void mid(f32x4 (&)[2][2][4][2], const Unit&, int, int, int, int, int) const {}
    __device__ __forceinline__ void operator()(const f32x4 (&acc)[2][2][4][2], const Unit& u, int wr, int wc, int fr, int fq) const {
        int fr_ = fr, fq_ = fq; asm volatile("" : "+v"(fr_), "+v"(fq_));
        float rsv[8]; row_scales(rsv, rstab, wr, fr_);
#pragma unroll
        for (int i = 0; i < 8; ++i) rsv[i] *= (1.0f / 64.0f);
        const int pn = u.pn;
        if (pn >= 48) { const int row0 = u.pm * BM + wr * 64 + fr_, cl = wc * 32 + 8 * fq_;
            bf16_t* const CQ = (bf16_t*)(ws + L::CQ); bf16_t* const CKV = (bf16_t*)(ws + L::CKV); bf16_t* const GO = (bf16_t*)(ws + L::GO); bf16_t* const KR = (bf16_t*)(ws + L::KR);
            ssq_t* const ssqq = (ssq_t*)(ws + L::SSQQ) + lrow; ssq_t* const ssqk = (ssq_t*)(ws + L::SSQK) + lrow;
            if (pn < 52)      epi_tile<0, true>(acc, CQ, 1024, row0, (pn - 48) * 256 + cl, false, ssqq, fq_, rsv);
            else if (pn < 54) epi_tile<0, true>(acc, CKV, 512, row0, (pn - 52) * 256 + cl, false, ssqk, fq_, rsv);
            else if (pn < 62) epi_tile<1>(acc, GO, 4096, row0, (pn - 54) * 256 + cl, false, nullptr, fq_, rsv);
            else { if (wc < 2) epi_tile<0>(acc, KR, 64, row0, cl, true, nullptr, fq_, rsv); }
            return; }
        bf16_t* bp = (bf16_t*)(ws + L::R) + ((((size_t)u.pm * 48 + pn) * 8 + (wr * 4 + wc)) * 16) * 512 + (size_t)(fq_ * 16 + fr_) * 8;
#pragma unroll
        for (int ai = 0; ai < 2; ++ai)
#pragma unroll
            for (int m = 0; m < 4; ++m) { const float rs = rsv[ai * 4 + m] * -LOG2E;
#define PG8_SG(t_) __builtin_amdgcn_exp2f(fminf(t_, 100.0f))
#pragma unroll
                for (int bj = 0; bj < 2; ++bj) { const f32x4 v0 = acc[ai][bj][m][0] * rs, v1 = acc[ai][bj][m][1] * rs; u32x4 w;
                    w.x = cvt_pk_bf16(PG8_SG(v0[0]), PG8_SG(v0[1])); w.y = cvt_pk_bf16(PG8_SG(v0[2]), PG8_SG(v0[3])); w.z = cvt_pk_bf16(PG8_SG(v1[0]), PG8_SG(v1[1])); w.w = cvt_pk_bf16(PG8_SG(v1[2]), PG8_SG(v1[3]));
                    *(u32x4*)(bp + (size_t)(((ai * 4 + m) * 2 + bj) * 512)) = w; } }
#undef PG8_SG
    }
};

struct EpiProj {
    static constexpr bool FP8 = false; static constexpr int MIXT = 16;
    static constexpr bool PERM = true, AFTER_DRAIN = false, HOOK = true; static constexpr int HOOK_T0 = 16, HOOK_T1 = 32;
    const bf16_t* R; bf16_t* O;
    __device__ __forceinline__ const bf16_t* blobp(const Unit& u, int branch, int wr, int wc, int fr, int fq) const {
        return R + ((((size_t)u.pm * 48 + (branch * 16 + u.pn)) * 8 + (wr * 4 + wc)) * 16) * 512 + (size_t)(fq * 16 + fr) * 8; }
    __device__ __forceinline__ void mid(f32x4 (&acc)[2][2][4][2], const Unit& u, int wr, int wc, int fr, int fq, int which) const {
        int fr_ = fr, fq_ = fq; asm volatile("" : "+v"(fr_), "+v"(fq_));
        const bf16_t* pa = blobp(u, which, wr, wc, fr_, fq_); const bf16_t* pb = pa + (size_t)16 * 8 * 16 * 512;
        const float sc_ = which ? 1.0f : (1.0f / 1024.0f);
#pragma unroll
        for (int ai = 0; ai < 2; ++ai) {
            u32x4 ra[8], rb[8];
#pragma unroll
            for (int q = 0; q < 8; ++q) { ra[q] = *(const u32x4*)(pa + (ai * 8 + q) * 512); rb[q] = *(const u32x4*)(pb + (ai * 8 + q) * 512); }
            __builtin_amdgcn_sched_barrier(0);
#pragma unroll
            for (int m = 0; m < 4; ++m)
#pragma unroll
                for (int bj = 0; bj < 2; ++bj) { const int q = m * 2 + bj;
#pragma unroll
                    for (int e = 0; e < 4; ++e) { const unsigned wa = ra[q][e], wb = rb[q][e];
                        const float f0 = (1.0f + bf_lo(wb)) * sc_ * __builtin_amdgcn_rcpf(1.0f + bf_lo(wa)), f1 = (1.0f + bf_hi(wb)) * sc_ * __builtin_amdgcn_rcpf(1.0f + bf_hi(wa));
                        if (e < 2) { acc[ai][bj][m][0][2 * e] *= f0; acc[ai][bj][m][0][2 * e + 1] *= f1; } else { acc[ai][bj][m][1][2 * (e - 2)] *= f0; acc[ai][bj][m][1][2 * (e - 2) + 1] *= f1; } } }
            __builtin_amdgcn_sched_barrier(0);
        }
    }
    __device__ __forceinline__ void operator()(const f32x4 (&acc)[2][2][4][2], const Unit& u, int wr, int wc, int fr, int fq) const {
        int fr_ = fr, fq_ = fq; asm volatile("" : "+v"(fr_), "+v"(fq_));
        const int row0 = u.pm * BM + wr * 64 + fr_, col0 = u.pn * BM + wc * 32 + 8 * fq_;
        const bf16_t* pc = blobp(u, 2, wr, wc, fr_, fq_);
        u32x4 rq[16];
#pragma unroll
        for (int q = 0; q < 16; ++q) rq[q] = *(const u32x4*)(pc + q * 512);
        __builtin_amdgcn_sched_barrier(0);
#pragma unroll
        for (int ai = 0; ai < 2; ++ai)
#pragma unroll
            for (int m = 0; m < 4; ++m) { bf16_t* op = O + (size_t)(row0 + ai * HALF + m * 16) * 4096 + col0;
#pragma unroll
                for (int bj = 0; bj < 2; ++bj) { const u32x4 rc = rq[(ai * 4 + m) * 2 + bj]; const f32x4 v0 = acc[ai][bj][m][0], v1 = acc[ai][bj][m][1];
                    u32x4 w;
#define PG8_R2(x_) __builtin_amdgcn_rcpf(1.0f + (x_))
                    w.x = cvt_pk_bf16(v0[0] * PG8_R2(bf_lo(rc.x)), v0[1] * PG8_R2(bf_hi(rc.x))); w.y = cvt_pk_bf16(v0[2] * PG8_R2(bf_lo(rc.y)), v0[3] * PG8_R2(bf_hi(rc.y)));
                    w.z = cvt_pk_bf16(v1[0] * PG8_R2(bf_lo(rc.z)), v1[1] * PG8_R2(bf_hi(rc.z))); w.w = cvt_pk_bf16(v1[2] * PG8_R2(bf_lo(rc.w)), v1[3] * PG8_R2(bf_hi(rc.w)));
#undef PG8_R2
                    *(u32x4*)(op + bj * HALF) = w; } }
    }
};

struct EpiOut {
    static constexpr bool FP8 = false; static constexpr int MIXT = 0;
    static constexpr bool PERM = true, AFTER_DRAIN = false, HOOK = false; static constexpr int HOOK_T0 = -1, HOOK_T1 = -1;
    const float* xin; float* out; bf16_t* xb; unsigned char* x8; ssq_t* ssqo;
    __device__ __forceinline__ void mid(f32x4 (&)[2][2][4][2], const Unit&, int, int, int, int, int) const {}
    __device__ __forceinline__ void operator()(const f32x4 (&acc)[2][2][4][2], const Unit& u, int wr, int wc, int fr, int fq) const {
        int fr_ = fr, fq_ = fq; asm volatile("" : "+v"(fr_), "+v"(fq_));
        const int row0 = u.pm * BM + wr * 64 + fr_, col0 = u.pn * BM + wc * 32 + 8 * fq_;
#pragma unroll
        for (int ai = 0; ai < 2; ++ai) {
            f32x4 xr[4][2][2];
#pragma unroll
            for (int m = 0; m < 4; ++m) { const size_t off = (size_t)(row0 + ai * HALF + m * 16) * 4096 + col0;
#pragma unroll
                for (int bj = 0; bj < 2; ++bj) { xr[m][bj][0] = *(const f32x4*)(xin + off + bj * HALF); xr[m][bj][1] = *(const f32x4*)(xin + off + bj * HALF + 4); } }
            __builtin_amdgcn_sched_barrier(0);
#pragma unroll
            for (int m = 0; m < 4; ++m) { const size_t off = (size_t)(row0 + ai * HALF + m * 16) * 4096 + col0; float sq = 0.f;
#pragma unroll
                for (int bj = 0; bj < 2; ++bj) { const f32x4 y0 = xr[m][bj][0] + acc[ai][bj][m][0], y1 = xr[m][bj][1] + acc[ai][bj][m][1];
                    *(f32x4*)(out + off + bj * HALF) = y0; *(f32x4*)(out + off + bj * HALF + 4) = y1;
                    if (xb) { u32x4 w; w.x = cvt_pk_bf16(y0[0], y0[1]); w.y = cvt_pk_bf16(y0[2], y0[3]); w.z = cvt_pk_bf16(y1[0], y1[1]); w.w = cvt_pk_bf16(y1[2], y1[3]); *(u32x4*)(xb + off + bj * HALF) = w;
                        { int p0 = __builtin_amdgcn_cvt_pk_fp8_f32(y0[0], y0[1], 0, false); p0 = __builtin_amdgcn_cvt_pk_fp8_f32(y0[2], y0[3], p0, true); int p1 = __builtin_amdgcn_cvt_pk_fp8_f32(y1[0], y1[1], 0, false); p1 = __builtin_amdgcn_cvt_pk_fp8_f32(y1[2], y1[3], p1, true);
                          typedef int i32x2 __attribute__((ext_vector_type(2))); *(i32x2*)(x8 + off + bj * HALF) = (i32x2){p0, p1}; }
                        sq += (y0[0] * y0[0] + y0[1] * y0[1]) + (y0[2] * y0[2] + y0[3] * y0[3]) + (y1[0] * y1[0] + y1[1] * y1[1]) + (y1[2] * y1[2] + y1[3] * y1[3]); } }
                if (xb) { sq += shflx(sq, 16); sq += shflx(sq, 32); if (fq_ == 0) ssq_add(ssqo + row0 + ai * HALF + m * 16, sq); } }
            __builtin_amdgcn_sched_barrier(0);
        }
    }
};

template <class Epi, class Sched, bool ALIGN_EPI = false, bool SP2 = false>
__device__ __forceinline__ void gemm_phase(PG8_LAS unsigned char* lds, const Gemm g, const Sched& S, const Epi& E, int tid_in) {
    int tid_ = tid_in; asm volatile("" : "+v"(tid_));
    const int tid = tid_, wid = __builtin_amdgcn_readfirstlane(tid >> 6), lane = tid & 63, wr = wid >> 2, wc = wid & 3, fr = lane & 15, fq = lane >> 4;
    const int K = g.K, LD = g.ld ? g.ld : g.K, nt = K / BK;
    unsigned voffA[2], voffB[2];
#pragma unroll
    for (int i = 0; i < 2; ++i) { int R, C; stage_rc(tid * 16 + i * 8192, R, C); const int Rb = Epi::PERM ? ((R & ~31) + perm32(R & 31)) : R;
        voffA[i] = (unsigned)(R * LD + C) * 2u; voffB[i] = (unsigned)(Rb * LD + C) * 2u; }
    const __amdgpu_buffer_rsrc_t rsA = __builtin_amdgcn_make_buffer_rsrc((void*)g.A, 0, -1, 0x00020000), rsB = __builtin_amdgcn_make_buffer_rsrc((void*)g.Bt, 0, -1, 0x00020000);
    const size_t kstep = (size_t)(BK * 2);
    const size_t hstep = (size_t)HALF * LD * 2;
    const size_t tstep = 2 * hstep;
    const unsigned ldsw = (unsigned)wid * 1024u;
    const int aoff = lds_byte(wr * 64 + fr, fq * 8), boff = lds_byte(wc * 32 + fr, fq * 8);
#define PG8_SA(b, h) (((b) * 2 + (h)) * HTB)
#define PG8_SB(b, h) ((4 + (b) * 2 + (h)) * HTB)
#define PG8_STAGE(bufoff, gbase, voff) do { const bool isA_ = (&(voff)[0] == &voffA[0]); const unsigned so_ = (unsigned)((const char*)(gbase) - (isA_ ? (const char*)g.A : (const char*)g.Bt)); \
        _Pragma("unroll") for (int _i = 0; _i < 2; ++_i) __builtin_amdgcn_raw_ptr_buffer_load_lds(isA_ ? rsA : rsB, (PG8_LAS unsigned*)(lds + (bufoff) + ldsw + _i * 8192), 16, (int)(voff)[_i], (int)so_, 0, 0); } while (0)
#define PG8_LD8(p_) __builtin_shufflevector(*(const PG8_LAS i32x4*)(p_), *(const PG8_LAS i32x4*)((p_) + 1024), 0, 1, 2, 3, 4, 5, 6, 7)
#define PG8_LDA(F8, dst, b, h) do { if constexpr (F8) { _Pragma("unroll") for (int m = 0; m < 4; ++m) dst##8[m] = PG8_LD8(lds + PG8_SA(b, h) + aoff + m * 2048); } \
        else { _Pragma("unroll") for (int m = 0; m < 4; ++m) _Pragma("unroll") for (int k = 0; k < 2; ++k) dst[m][k] = *(const PG8_LAS bf16x8*)(lds + PG8_SA(b, h) + aoff + m * 2048 + k * 1024); } } while (0)
#define PG8_LDB(F8, dst, b, h) do { if constexpr (F8) { _Pragma("unroll") for (int n = 0; n < 2; ++n) dst##8[n] = PG8_LD8(lds + PG8_SB(b, h) + boff + n * 2048); } \
        else { _Pragma("unroll") for (int n = 0; n < 2; ++n) _Pragma("unroll") for (int k = 0; k < 2; ++k) dst[n][k] = *(const PG8_LAS bf16x8*)(lds + PG8_SB(b, h) + boff + n * 2048 + k * 1024); } } while (0)
#define PG8_MMA(F8, ai, bj, At, Bt) do { __builtin_amdgcn_s_setprio(1); _Pragma("unroll") for (int m = 0; m < 4; ++m) _Pragma("unroll") for (int n = 0; n < 2; ++n) { \
        if constexpr (F8) acc[ai][bj][m][n] = __builtin_amdgcn_mfma_scale_f32_16x16x128_f8f6f4(Bt##8[n], At##8[m], acc[ai][bj][m][n], 0, 0, 0, 0, 0, 0);        \
        else { _Pragma("unroll") for (int k = 0; k < 2; ++k) acc[ai][bj][m][n] = __builtin_amdgcn_mfma_f32_16x16x32_bf16(Bt[n][k], At[m][k], acc[ai][bj][m][n], 0, 0, 0); } } \
        __builtin_amdgcn_s_setprio(0); } while (0)
#define PG8_WAIT_V(n) asm volatile("s_waitcnt vmcnt(" #n ")" ::: "memory")
#define PG8_WAIT_L(n) asm volatile("s_waitcnt lgkmcnt(" #n ")" ::: "memory")
#define PG8_BAR __builtin_amdgcn_s_barrier()
#define PG8_SCHED __builtin_amdgcn_sched_barrier(0)
#define PG8_KO(v) ((size_t)((Epi::MIXT > 0 && (v) >= Epi::MIXT) ? (v) + Epi::MIXT : (v)) * kstep)
#define PG8_KLOOP(F8_)         for (int t = tb_; t < te_; t += 2) { \
            const bool last = (t == nt - 2); \
            const char* a1 = cA + PG8_KO(t + 1); \
            const char* a2 = last ? nA : cA + PG8_KO(t + 2); const char* b2 = last ? nB : cB + PG8_KO(t + 2); \
            const char* a3 = a2 + kstep; const char* b3 = b2 + kstep; \
            if (last && has_next) S.a_ready(nxt); \
            if constexpr (SP2) { \
            PG8_LDB(F8_, B0, 0, 0); PG8_LDB(F8_, B1, 0, 1); PG8_SCHED; PG8_LDA(F8_, At, 0, 0); PG8_STAGE(PG8_SA(1, 1), a1 + hstep, voffA); \
            PG8_WAIT_V(8); PG8_WAIT_L(0); PG8_BAR; PG8_MMA(F8_, 0, 0, At, B0); PG8_MMA(F8_, 0, 1, At, B1); PG8_BAR; PG8_SCHED; \
            PG8_LDA(F8_, At, 0, 1); PG8_STAGE(PG8_SB(0, 0), b2, voffB); PG8_STAGE(PG8_SB(0, 1), b2 + hstep, voffB); PG8_STAGE(PG8_SA(0, 0), a2, voffA); \
            PG8_WAIT_V(8); PG8_WAIT_L(0); PG8_BAR; PG8_MMA(F8_, 1, 0, At, B0); PG8_MMA(F8_, 1, 1, At, B1); PG8_BAR; PG8_SCHED; \
            PG8_LDB(F8_, B0, 1, 0); PG8_LDB(F8_, B1, 1, 1); PG8_SCHED; PG8_LDA(F8_, At, 1, 0); PG8_STAGE(PG8_SA(0, 1), a2 + hstep, voffA); \
            PG8_WAIT_V(8); PG8_WAIT_L(0); PG8_BAR; PG8_MMA(F8_, 0, 0, At, B0); PG8_MMA(F8_, 0, 1, At, B1); PG8_BAR; PG8_SCHED; \
            PG8_LDA(F8_, At, 1, 1); PG8_STAGE(PG8_SB(1, 0), b3, voffB); PG8_STAGE(PG8_SB(1, 1), b3 + hstep, voffB); PG8_STAGE(PG8_SA(1, 0), a3, voffA); \
            PG8_WAIT_V(8); PG8_WAIT_L(0); PG8_BAR; PG8_MMA(F8_, 1, 0, At, B0); PG8_MMA(F8_, 1, 1, At, B1); PG8_BAR; PG8_SCHED; \
            } else { \
            PG8_LDB(F8_, B0, 0, 0); PG8_SCHED; PG8_LDA(F8_, At, 0, 0); PG8_STAGE(PG8_SA(1, 1), a1 + hstep, voffA); \
            PG8_WAIT_L(8); PG8_BAR; PG8_WAIT_L(0); PG8_MMA(F8_, 0, 0, At, B0); PG8_BAR; PG8_SCHED; \
            PG8_LDB(F8_, B1, 0, 1); PG8_STAGE(PG8_SB(0, 0), b2, voffB); \
            PG8_BAR; PG8_WAIT_L(0); PG8_MMA(F8_, 0, 1, At, B1); PG8_BAR; \
            PG8_LDA(F8_, At, 0, 1); PG8_STAGE(PG8_SA(0, 0), a2, voffA); \
            PG8_BAR; PG8_WAIT_L(0); PG8_MMA(F8_, 1, 0, At, B0); PG8_BAR; PG8_SCHED; \
            PG8_STAGE(PG8_SB(0, 1), b2 + hstep, voffB); \
            PG8_WAIT_V(6); PG8_BAR; PG8_MMA(F8_, 1, 1, At, B1); PG8_BAR; \
            PG8_LDB(F8_, B0, 1, 0); PG8_SCHED; PG8_LDA(F8_, At, 1, 0); PG8_STAGE(PG8_SA(0, 1), a2 + hstep, voffA); \
            PG8_WAIT_L(8); PG8_BAR; PG8_WAIT_L(0); PG8_MMA(F8_, 0, 0, At, B0); PG8_BAR; PG8_SCHED; \
            PG8_LDB(F8_, B1, 1, 1); PG8_STAGE(PG8_SB(1, 0), b3, voffB); \
            PG8_BAR; PG8_WAIT_L(0); PG8_MMA(F8_, 0, 1, At, B1); PG8_BAR; \
            PG8_LDA(F8_, At, 1, 1); PG8_STAGE(PG8_SA(1, 0), a3, voffA); \
            PG8_BAR; PG8_WAIT_L(0); PG8_MMA(F8_, 1, 0, At, B0); PG8_BAR; PG8_SCHED; \
            PG8_STAGE(PG8_SB(1, 1), b3 + hstep, voffB); \
            PG8_WAIT_V(6); PG8_BAR; PG8_MMA(F8_, 1, 1, At, B1); PG8_BAR; \
            } \
        }
    Unit cur, nxt; int ui = 0;
    if (!S.next(0, cur)) return;
    f32x4 acc[2][2][4][2];
#pragma unroll
    for (int a = 0; a < 2; ++a)
#pragma unroll
        for (int b = 0; b < 2; ++b)
#pragma unroll
            for (int m = 0; m < 4; ++m)
#pragma unroll
                for (int n = 0; n < 2; ++n) acc[a][b][m][n] = (f32x4){0.f, 0.f, 0.f, 0.f};
    bf16x8 At[4][2], B0[2][2], B1[2][2];
    i32x8 At8[4], B08[2], B18[2];
    const char* cA = (const char*)g.A + (size_t)cur.pm * tstep; const char* cB = (const char*)g.Bt + (size_t)cur.pn * tstep;
    S.a_ready(cur);
    if constexpr (SP2) {
        PG8_STAGE(PG8_SB(0, 0), cB, voffB); PG8_STAGE(PG8_SB(0, 1), cB + hstep, voffB); PG8_STAGE(PG8_SA(0, 0), cA, voffA); PG8_STAGE(PG8_SA(0, 1), cA + hstep, voffA);
        if (wr == 1) PG8_BAR;
        PG8_WAIT_V(2); PG8_BAR;
        PG8_STAGE(PG8_SB(1, 0), cB + kstep, voffB); PG8_STAGE(PG8_SA(1, 0), cA + kstep, voffA); PG8_STAGE(PG8_SB(1, 1), cB + hstep + kstep, voffB);
        PG8_WAIT_V(6); PG8_BAR;
    } else {
        PG8_STAGE(PG8_SB(0, 0), cB, voffB); PG8_STAGE(PG8_SA(0, 0), cA, voffA); PG8_STAGE(PG8_SB(0, 1), cB + hstep, voffB); PG8_STAGE(PG8_SA(0, 1), cA + hstep, voffA);
        if (wr == 1) PG8_BAR;
        PG8_WAIT_V(4); PG8_BAR;
        PG8_STAGE(PG8_SB(1, 0), cB + kstep, voffB); PG8_STAGE(PG8_SA(1, 0), cA + kstep, voffA); PG8_STAGE(PG8_SB(1, 1), cB + hstep + kstep, voffB);
        PG8_WAIT_V(6); PG8_BAR;
    }
    for (;;) {
        const bool has_next = S.next(ui + 1, nxt);
        const char* nA = has_next ? (const char*)g.A + (size_t)nxt.pm * tstep : cA; const char* nB = has_next ? (const char*)g.Bt + (size_t)nxt.pn * tstep : cB;
        if constexpr (Epi::MIXT > 0) {
            static_assert(Epi::HOOK && Epi::MIXT == Epi::HOOK_T0, "the e4m3 K-tiles are exactly the first segment");
            { const int tb_ = 0, te_ = Epi::HOOK_T0; PG8_KLOOP(true) }
            { int te2_ = fresh_lane(); asm volatile("" : "+v"(te2_)); E.mid(acc, cur, wr, wc, te2_ & 15, (te2_ >> 4) & 3, 0); }
            for (int seg = 1; seg < 3; ++seg) { const int tb_ = (seg == 1) ? Epi::HOOK_T0 : Epi::HOOK_T1, te_ = (seg == 1) ? Epi::HOOK_T1 : nt; PG8_KLOOP(false)
                if (seg == 1) { int te2_ = fresh_lane(); asm volatile("" : "+v"(te2_)); E.mid(acc, cur, wr, wc, te2_ & 15, (te2_ >> 4) & 3, 1); } }
        } else {
        constexpr int NSEG = Epi::HOOK ? 3 : 1; int tb_ = 0;
        for (int seg = 0; seg < NSEG; ++seg) { const int te_ = (NSEG == 1 || seg == 2) ? nt : (seg == 0 ? Epi::HOOK_T0 : Epi::HOOK_T1);
        PG8_KLOOP(Epi::FP8)
        if constexpr (Epi::HOOK) { if (seg < 2) { int te2_ = fresh_lane(); asm volatile("" : "+v"(te2_)); E.mid(acc, cur, wr, wc, te2_ & 15, (te2_ >> 4) & 3, seg); } } tb_ = te_; }
        }
        if constexpr (ALIGN_EPI) { if (wr == 0) PG8_BAR; }
        if constexpr (!Epi::AFTER_DRAIN) { int te2_ = fresh_lane(); asm volatile("" : "+v"(te2_)); E(acc, cur, wr, wc, te2_ & 15, (te2_ >> 4) & 3); S.done(cur); }
        if (!has_next) break;
#pragma unroll
        for (int a = 0; a < 2; ++a)
#pragma unroll
            for (int b = 0; b < 2; ++b)
#pragma unroll
                for (int m = 0; m < 4; ++m)
#pragma unroll
                    for (int n = 0; n < 2; ++n) acc[a][b][m][n] = (f32x4){0.f, 0.f, 0.f, 0.f};
        cur = nxt; cA = nA; cB = nB; ++ui;
        if constexpr (ALIGN_EPI) { if (wr == 1) PG8_BAR; }
    }
    PG8_WAIT_V(0);
    if constexpr (!ALIGN_EPI) { if (wr == 0) PG8_BAR; }
    PG8_BAR;
    if constexpr (Epi::AFTER_DRAIN) { E.fused(acc, cur, wr, wc, fr, fq, lds, wid, lane); S.done(cur); }
#undef PG8_SA
#undef PG8_SB
#undef PG8_STAGE
#undef PG8_LDA
#undef PG8_LDB
#undef PG8_MMA
#undef PG8_KLOOP
#undef PG8_KO
#undef PG8_LD8
#undef PG8_WAIT_V
#undef PG8_WAIT_L
#undef PG8_BAR
#undef PG8_SCHED
}
}

constexpr int BATCH = 2, SEQ = 8192, DM = 4096, DEPTH = 4, M = BATCH * SEQ;
constexpr int NIN = 22080;
constexpr int NB16 = 6144;
constexpr int NG8 = 16128;
constexpr int MEMLEN = 256;
constexpr float EPS = 1e-6f;
constexpr int NWAVES = 8, NTHREADS = 512;

constexpr size_t al256(size_t x) { return (x + 255) & ~(size_t)255; }
constexpr size_t WS_CTL = 0, CTL_ZERO_BYTES = 2u << 20;
constexpr size_t SZ_WIN = (size_t)NB16 * 4096 * 2, SZ_W8 = (size_t)NG8 * 4096, SZ_WUQ = (size_t)3072 * 1024 * 2, SZ_WUKV = (size_t)4096 * 512 * 2, SZ_WPROJ = (size_t)4096 * 4096 * 2, SZ_WOUT = (size_t)4096 * 4096 * 2;
constexpr size_t SZ_WMKV = (size_t)2048 * 4096 * 2;
constexpr size_t WL_WIN = 0, WL_W8 = WL_WIN + SZ_WIN, WL_WUQ = WL_W8 + SZ_W8, WL_WUKV = WL_WUQ + SZ_WUQ, WL_WPROJ = WL_WUKV + SZ_WUKV, WL_WOUT = WL_WPROJ + SZ_WPROJ, WL_STRIDE = WL_WOUT + SZ_WOUT;
constexpr size_t WS_W = CTL_ZERO_BYTES;
constexpr size_t WS_WMKV = WS_W + DEPTH * WL_STRIDE;
constexpr size_t WS_H = WS_WMKV + DEPTH * SZ_WMKV;
constexpr size_t WS_MEMN = WS_H + (size_t)M * 4096 * 2;
constexpr size_t WS_CQ = WS_MEMN + (size_t)512 * 4096 * 2;
constexpr size_t WS_CKV = WS_CQ + (size_t)M * 1024 * 2;
constexpr size_t WS_KR = WS_CKV + (size_t)M * 512 * 2;
constexpr size_t WS_GO = WS_KR + (size_t)M * 64 * 2;
constexpr size_t WS_QKVB = WS_GO + (size_t)M * 4096 * 2;
constexpr size_t WS_QM = WS_QKVB + (size_t)M * 3072 * 2;
constexpr size_t WS_R = WS_QM + (size_t)M * 1024 * 2;
constexpr size_t WS_QAR = WS_R + (size_t)M * 12288 * 2;
constexpr size_t WS_KVA = WS_QAR + (size_t)M * 3072 * 2;
constexpr size_t WS_QA = WS_KVA + (size_t)M * 4096 * 2;
constexpr size_t WS_KA = WS_QA + (size_t)M * 3072 * 2;
constexpr size_t WS_VTA = WS_KA + (size_t)M * 3072 * 2;
constexpr size_t WS_VTB = WS_VTA + (size_t)M * 2048 * 2;
constexpr size_t WS_QMN = WS_VTB + (size_t)M * 1024 * 2;
constexpr size_t WS_MIXB = WS_QMN + (size_t)M * 1024 * 2;
constexpr size_t WS_KVM = WS_MIXB + (size_t)M * 4096 * 2;
constexpr size_t WS_KM = WS_KVM + (size_t)512 * 8192 * 2;
constexpr size_t WS_VTM = WS_KM + (size_t)DEPTH * 2 * 4 * 256 * 256 * 2;
constexpr size_t WS_ROPE = WS_VTM + (size_t)DEPTH * 2 * 4 * 256 * 256 * 2;
constexpr size_t WS_OC = WS_ROPE + (size_t)M * 32 * 4 * 2;
constexpr size_t WS_XA = WS_OC + (size_t)M * 4096 * 2;
constexpr size_t WS_H8 = WS_XA + (size_t)M * 4096 * 4;
constexpr size_t WS_END = WS_H8 + (size_t)M * 4096;
static_assert(WS_W % 256 == 0 && WL_STRIDE % 256 == 0 && WS_END % 256 == 0, "ws map alignment");
constexpr size_t CTL_SSQX = 65536, CTL_SSQQ = CTL_SSQX + (size_t)DEPTH * M * 8, CTL_SSQK = CTL_SSQQ + (size_t)DEPTH * M * 8;
static_assert(CTL_SSQK + (size_t)DEPTH * M * 8 <= CTL_ZERO_BYTES, "row statistics inside the zeroed control region");
struct WsL { static constexpr size_t KFB = WS_KA + (size_t)M * 3072, CQ = WS_CQ, CKV = WS_CKV, KR = WS_KR, GO = WS_GO, QKVB = WS_QKVB, QM = WS_QM, R = WS_R, SSQQ = WS_CTL + CTL_SSQQ, SSQK = WS_CTL + CTL_SSQK; };
constexpr int CW_BAR = 4096;

constexpr int RING_BYTES = 131072;
constexpr int MISC_OFF = RING_BYTES + 320;
constexpr int RSTAB_OFF = RING_BYTES + 1024;
constexpr int LDS_BYTES = 147456;

#define GAS __attribute__((address_space(1)))
#define LAS __attribute__((address_space(3)))
typedef unsigned short bf16;
typedef unsigned v4u __attribute__((ext_vector_type(4)));
typedef unsigned v2u __attribute__((ext_vector_type(2)));
typedef float f32x4 __attribute__((ext_vector_type(4)));
typedef float f32x16 __attribute__((ext_vector_type(16)));
typedef short bf16x8 __attribute__((ext_vector_type(8)));
using pg8::cvt_pk_bf16; using pg8::bf_lo; using pg8::bf_hi; using pg8::LOG2E;
#define LDS_WAIT() asm volatile("s_waitcnt lgkmcnt(0)" ::: "memory")

#define XB_TMO      128
#define XB_XCNT(j)  (256  + 64 * (j))
#define XB_XSUB(j)  (1280 + 64 * (j))
#define XB_XGEN(j)  (2304 + 64 * (j))
#define XB_TOP      3328
#define XB_TOPGEN   3392
#define XCD_BAR_WORDS 3456
#define XB_SPIN_CAP (1u << 18)

__device__ __forceinline__ unsigned xb_ld(unsigned* p)              { return __hip_atomic_load(p, __ATOMIC_RELAXED, __HIP_MEMORY_SCOPE_AGENT); }
__device__ __forceinline__ unsigned xb_add(unsigned* p, unsigned v) { return __hip_atomic_fetch_add(p, v, __ATOMIC_RELAXED, __HIP_MEMORY_SCOPE_AGENT); }
__device__ __forceinline__ unsigned xb_xcc_id() { return (unsigned)__builtin_amdgcn_s_getreg((3 << 11) | 20) & 0xFu; }
#define XB_SPIN(cond, bar) do { unsigned _sp = 0; while (cond) { __builtin_amdgcn_s_sleep(1); \
    if ((++_sp & 255u) == 0u) { if (xb_ld(&(bar)[XB_TMO])) break; if (_sp > XB_SPIN_CAP) { atomicAdd(&(bar)[XB_TMO], 1u); break; } } } } while (0)

struct XcdBarrier {
    unsigned* bar; unsigned x; int w;
    volatile LAS unsigned* st;
};

__device__ __forceinline__ XcdBarrier xcd_barrier_post(unsigned* bar, volatile LAS unsigned* st, int wave) {
    XcdBarrier b; b.bar = bar; b.x = xb_xcc_id(); b.st = st; b.w = wave;
    if (threadIdx.x == 0) (void)xb_add(&bar[XB_XCNT(b.x)], 1u);
    return b;
}
__device__ __forceinline__ void xcd_barrier_complete(unsigned* bar, unsigned x, unsigned& nloc, unsigned& nx) {
    const unsigned G = gridDim.x * gridDim.y * gridDim.z;
    unsigned sum, cnt, mine, sp = 0u;
    for (;;) {
        sum = 0u; cnt = 0u; mine = 0u;
#pragma unroll
        for (unsigned j = 0; j < 16; ++j) { const unsigned c = xb_ld(&bar[XB_XCNT(j)]); sum += c; cnt += (c > 0u) ? 1u : 0u; mine = (j == x) ? c : mine; }
        if (sum == G) break;
        __builtin_amdgcn_s_sleep(1);
        if ((++sp & 255u) == 0u) { if (xb_ld(&bar[XB_TMO])) break; if (sp > XB_SPIN_CAP) { atomicAdd(&bar[XB_TMO], 1u); break; } }
    }
    nloc = mine > 0u ? mine : 1u; nx = cnt > 0u ? cnt : 1u;
}

__device__ __forceinline__ void xcd_barrier(const XcdBarrier& b) {
    asm volatile("s_waitcnt vmcnt(0)" ::: "memory");
    __syncthreads();
    if (b.w == 0 && fresh_lane() == 0) {
        unsigned bx_ = b.x; asm volatile("" : "+s"(bx_));
        unsigned* bar = b.bar; asm volatile("" : "+s"(bar));
        __builtin_amdgcn_s_waitcnt(0);
        unsigned nloc = b.st[0], nx = b.st[1];
        if (nloc == 0u) { xcd_barrier_complete(bar, bx_, nloc, nx); b.st[0] = nloc; b.st[1] = nx; }
        const unsigned old = xb_add(&bar[XB_XSUB(bx_)], 1u);
        const unsigned gen = old / nloc;
        if (old + 1u == (gen + 1u) * nloc) {
            __builtin_amdgcn_fence(__ATOMIC_RELEASE, "agent");
            asm volatile("s_waitcnt vmcnt(0)" ::: "memory");
            const unsigned og = xb_add(&bar[XB_TOP], 1u);
            const unsigned tg = og / nx;
            if (og + 1u == (tg + 1u) * nx) xb_add(&bar[XB_TOPGEN], 1u);
            else XB_SPIN(xb_ld(&bar[XB_TOPGEN]) == tg, bar);
            __builtin_amdgcn_fence(__ATOMIC_ACQUIRE, "agent");
            xb_add(&bar[XB_XGEN(bx_)], 1u);
            asm volatile("s_waitcnt vmcnt(0)" ::: "memory");
        } else {
            XB_SPIN(xb_ld(&bar[XB_XGEN(bx_)]) == gen, bar);
            __builtin_amdgcn_fence(__ATOMIC_ACQUIRE, "agent");
            asm volatile("s_waitcnt vmcnt(0)" ::: "memory");
        }
    }
    __syncthreads();
}

__device__ __forceinline__ float wave_sum(float v) {
#pragma unroll
    for (int o = 1; o < 64; o <<= 1) v += shflx(v, o);
    return v;
}
__device__ __forceinline__ float ssq8(v4u v) {
    float s = 0.f;
#pragma unroll
    for (int e = 0; e < 4; ++e) { const float a = bf_lo(v[e]), b = bf_hi(v[e]); s += a * a + b * b; }
    return s;
}
__device__ __forceinline__ int pi32(int i) { return (i & ~12) | ((i & 4) << 1) | ((i & 8) >> 1); }

struct TrDesc { const float* W; const float* gk; bf16* WT; size_t drow0; int N, k0, n0, ldk, koff, fp8; };
__device__ __forceinline__ void tr_load(const TrDesc& d, f32x4 (&v)[8], int lane) {
    const int kr = lane >> 3, n4 = (lane & 7) * 4;
#pragma unroll
    for (int i = 0; i < 8; ++i) v[i] = *(const f32x4*)(d.W + (size_t)(d.k0 + 8 * i + kr) * d.N + d.n0 + n4);
}
__device__ __forceinline__ void tr_finish(const TrDesc& d, const f32x4 (&v)[8], LAS float* scr, int lane) {
    { const int kr = lane >> 3, n4 = (lane & 7) * 4;
#pragma unroll
      for (int i = 0; i < 8; ++i) { LAS float* q = scr + (8 * i + kr) * 33 + n4; q[0] = v[i].x; q[1] = v[i].y; q[2] = v[i].z; q[3] = v[i].w; } }
    const int c = lane & 7;
    f32x4 g0 = {1.f, 1.f, 1.f, 1.f}, g1 = {1.f, 1.f, 1.f, 1.f};
    if (d.gk) { g0 = *(const f32x4*)(d.gk + d.k0 + 8 * c); g1 = *(const f32x4*)(d.gk + d.k0 + 8 * c + 4); }
    LDS_WAIT(); asm volatile("" ::: "memory");
    if (d.fp8) { g0 = g0 * 64.0f; g1 = g1 * 64.0f;
#pragma unroll
        for (int j = 0; j < 4; ++j) { const int n = (lane >> 3) + 8 * j; const LAS float* sp = scr + (8 * c) * 33 + n;
            int p0 = __builtin_amdgcn_cvt_pk_fp8_f32(sp[0 * 33] * g0.x, sp[1 * 33] * g0.y, 0, false); p0 = __builtin_amdgcn_cvt_pk_fp8_f32(sp[2 * 33] * g0.z, sp[3 * 33] * g0.w, p0, true);
            int p1 = __builtin_amdgcn_cvt_pk_fp8_f32(sp[4 * 33] * g1.x, sp[5 * 33] * g1.y, 0, false); p1 = __builtin_amdgcn_cvt_pk_fp8_f32(sp[6 * 33] * g1.z, sp[7 * 33] * g1.w, p1, true);
            *(v2u*)((unsigned char*)d.WT + (d.drow0 + n) * (size_t)d.ldk + d.k0 + 8 * c) = (v2u){(unsigned)p0, (unsigned)p1}; }
    } else {
#pragma unroll
    for (int j = 0; j < 4; ++j) { const int n = (lane >> 3) + 8 * j; const LAS float* sp = scr + (8 * c) * 33 + n;
        v4u o; o.x = cvt_pk_bf16(sp[0 * 33] * g0.x, sp[1 * 33] * g0.y); o.y = cvt_pk_bf16(sp[2 * 33] * g0.z, sp[3 * 33] * g0.w); o.z = cvt_pk_bf16(sp[4 * 33] * g1.x, sp[5 * 33] * g1.y); o.w = cvt_pk_bf16(sp[6 * 33] * g1.z, sp[7 * 33] * g1.w);
        *(v4u*)(d.WT + (d.drow0 + n) * (size_t)d.ldk + d.koff + d.k0 + 8 * c) = o; }
    }
    LDS_WAIT(); asm volatile("" ::: "memory");
}

__device__ __forceinline__ void transpose_64x64(const bf16* src, size_t spitch, bf16* dst, size_t dpitch, LAS unsigned char* scr, int lane) {
    const int p = lane & 7, t8 = lane >> 3;
    v4u v[8];
#pragma unroll
    for (int sub = 0; sub < 8; ++sub) v[sub] = *(const v4u*)(src + (size_t)(sub * 8 + t8) * spitch + 8 * p);
#pragma unroll
    for (int sub = 0; sub < 8; ++sub)
#pragma unroll
        for (int e = 0; e < 8; ++e) { const unsigned w = v[sub][e >> 1]; *(LAS unsigned short*)(scr + (8 * p + e) * 144 + (sub * 8 + t8) * 2) = (unsigned short)((e & 1) ? (w >> 16) : (w & 0xffffu)); }
    LDS_WAIT(); asm volatile("" ::: "memory");
#pragma unroll
    for (int i = 0; i < 8; ++i) { const int d = 8 * i + (lane >> 3), ch = lane & 7; const v4u x = *(const LAS v4u*)(scr + d * 144 + ch * 16); *(v4u*)(dst + (size_t)d * dpitch + 8 * ch) = x; }
    LDS_WAIT(); asm volatile("" ::: "memory");
}

__device__ __forceinline__ unsigned pk_fp8x4(float a, float b, float c, float d) { int p = __builtin_amdgcn_cvt_pk_fp8_f32(a, b, 0, false); p = __builtin_amdgcn_cvt_pk_fp8_f32(c, d, p, true); return (unsigned)p; }

__device__ __forceinline__ void transpose_64x64_f8(const bf16* src, size_t spitch, unsigned char* dst8, size_t dpitch, LAS unsigned char* scr, int lane) {
    const int p = lane & 7, t8 = lane >> 3;
    v4u v[8];
#pragma unroll
    for (int sub = 0; sub < 8; ++sub) v[sub] = *(const v4u*)(src + (size_t)(sub * 8 + t8) * spitch + 8 * p);
#pragma unroll
    for (int sub = 0; sub < 8; ++sub)
#pragma unroll
        for (int e = 0; e < 8; ++e) { const unsigned w = v[sub][e >> 1]; *(LAS unsigned short*)(scr + (8 * p + e) * 144 + (sub * 8 + t8) * 2) = (unsigned short)((e & 1) ? (w >> 16) : (w & 0xffffu)); }
    LDS_WAIT(); asm volatile("" ::: "memory");
#pragma unroll
    for (int i = 0; i < 8; ++i) { const int d = 8 * i + (lane >> 3), ch = lane & 7; const v4u x = *(const LAS v4u*)(scr + d * 144 + ch * 16);
        unsigned char* o8 = dst8 + (size_t)d * dpitch + 4 * ch;
        *(unsigned*)o8 = pk_fp8x4(bf_lo(x.x), bf_hi(x.x), bf_lo(x.y), bf_hi(x.y)); *(unsigned*)(o8 + 32) = pk_fp8x4(bf_lo(x.z), bf_hi(x.z), bf_lo(x.w), bf_hi(x.w)); }
    LDS_WAIT(); asm volatile("" ::: "memory");
}

__device__ __forceinline__ void transpose_64x64_frag(const bf16* src, size_t spitch, bf16* vf_bh, int tile0, int dh, LAS unsigned char* scr, int lane) {
    const int p = lane & 7, t8 = lane >> 3;
    v4u v[8];
#pragma unroll
    for (int sub = 0; sub < 8; ++sub) v[sub] = *(const v4u*)(src + (size_t)(sub * 8 + t8) * spitch + 8 * p);
#pragma unroll
    for (int sub = 0; sub < 8; ++sub)
#pragma unroll
        for (int e = 0; e < 8; ++e) { const unsigned w = v[sub][e >> 1]; *(LAS unsigned short*)(scr + (8 * p + e) * 144 + (sub * 8 + t8) * 2) = (unsigned short)((e & 1) ? (w >> 16) : (w & 0xffffu)); }
    LDS_WAIT(); asm volatile("" ::: "memory");
#pragma unroll
    for (int i = 0; i < 8; ++i) { const int d = 8 * i + (lane >> 3), ch = lane & 7; const v4u x = *(const LAS v4u*)(scr + d * 144 + ch * 16);
        const int db = dh * 2 + (d >> 5), r32 = d & 31, tl = ch >> 2, ks = (ch >> 1) & 1, hi = ch & 1;
        *(v4u*)(vf_bh + ((((size_t)(tile0 + tl) * 4 + db) * 2 + ks) * 64 + hi * 32 + r32) * 8) = x; }
    LDS_WAIT(); asm volatile("" ::: "memory");
}

template <int DQK, int NDB, bool FIXMAX, bool OUT8 = false>
__device__ __forceinline__ void attn_unit(const bf16* Qp, const bf16* Kp, const bf16* VTp, int vpitch, int NT, int cw, bool rev, const bf16* GOp, bf16* OCp, LAS unsigned char* lds, int tid_in) {
    int tid = tid_in; asm volatile("" : "+v"(tid));
    constexpr int KP = 2 * DQK + 16, VP = 144, VOFF = 64 * KP, BUF = VOFF + 32 * NDB * VP, CPR = DQK / 8, NKC = (64 * CPR) / 512, NKK = DQK / 16, NVC = NDB / 2;
    static_assert(2 * BUF <= RING_BYTES && (64 * CPR) % 512 == 0 && (NDB == 2 || NDB == 4), "attention LDS image");
    const int lane = tid & 63, wave = __builtin_amdgcn_readfirstlane(tid >> 6), r32 = lane & 31, hi = lane >> 5;
    bf16x8 qf[NKK];
#pragma unroll
    for (int kk = 0; kk < NKK; ++kk) qf[kk] = *(const bf16x8*)(Qp + (size_t)(wave * 32 + r32) * DQK + 16 * kk + 8 * hi);
    f32x16 o[NDB];
#pragma unroll
    for (int db = 0; db < NDB; ++db)
#pragma unroll
        for (int r = 0; r < 16; ++r) o[db][r] = 0.f;
    float m_run = -INFINITY, l_run = 0.f;
    const bf16* kg = Kp + 8 * tid; const bf16* vg = VTp + (size_t)(tid >> 3) * vpitch + 8 * (tid & 7);
#define AT_KL(t_, i) ((((t_) + 512 * (i)) / CPR) * KP + (((t_) + 512 * (i)) % CPR) * 16)
#define AT_VL(t_, i) (VOFF + (((t_) + 512 * (i)) >> 3) * VP + (((t_) + 512 * (i)) & 7) * 16)
    const int kfo = pi32(r32) * KP + 16 * hi, vfo = VOFF + r32 * VP + 16 * hi;
    v4u sk[NKC], sv[NVC];
    { const int tt0 = rev ? NT - 1 : 0;
#pragma unroll
    for (int i = 0; i < NKC; ++i) sk[i] = *(const v4u*)(kg + (size_t)tt0 * 64 * DQK + 4096 * i);
#pragma unroll
    for (int i = 0; i < NVC; ++i) sv[i] = *(const v4u*)(vg + (size_t)64 * i * vpitch + tt0 * 64); }
#pragma unroll
    for (int i = 0; i < NKC; ++i) *(LAS v4u*)(lds + AT_KL(tid, i)) = sk[i];
#pragma unroll
    for (int i = 0; i < NVC; ++i) *(LAS v4u*)(lds + AT_VL(tid, i)) = sv[i];
    __syncthreads();
    for (int t = 0; t < NT; ++t) {
        const bool more = (t + 1 < NT);
        const int tt = rev ? NT - 1 - t : t;
        if (more) { const int tn = rev ? tt - 1 : tt + 1;
#pragma unroll
            for (int i = 0; i < NKC; ++i) sk[i] = *(const v4u*)(kg + (size_t)tn * 64 * DQK + 4096 * i);
#pragma unroll
            for (int i = 0; i < NVC; ++i) sv[i] = *(const v4u*)(vg + (size_t)64 * i * vpitch + tn * 64);
        }
        if (tt <= cw) {
            LAS unsigned char* buf = lds + (t & 1) * BUF;
            f32x16 s0, s1;
#pragma unroll
            for (int r = 0; r < 16; ++r) { s0[r] = 0.f; s1[r] = 0.f; }
#define AT_KFRAG(i) (*(const LAS bf16x8*)(buf + kfo + ((i) & 1) * 32 * KP + 32 * ((i) >> 1)))
#define AT_VFRAG(i) (*(const LAS bf16x8*)(buf + vfo + 32 * ((i) >> 2) * VP + 32 * ((i) & 3)))
            bf16x8 ring[4];
            ring[0] = AT_KFRAG(0); ring[1] = AT_KFRAG(1); ring[2] = AT_KFRAG(2);
            __builtin_amdgcn_sched_barrier(0);
#pragma unroll
            for (int i = 0; i < 2 * NKK; ++i) {
                if (i + 3 < 2 * NKK) ring[(i + 3) & 3] = AT_KFRAG(i + 3);
                if (i & 1) s1 = __builtin_amdgcn_mfma_f32_32x32x16_bf16(ring[i & 3], qf[i >> 1], s1, 0, 0, 0); else s0 = __builtin_amdgcn_mfma_f32_32x32x16_bf16(ring[i & 3], qf[i >> 1], s0, 0, 0, 0);
                __builtin_amdgcn_sched_barrier(0);
            }
            ring[0] = AT_VFRAG(0); ring[1] = AT_VFRAG(1); ring[2] = AT_VFRAG(2);
            if constexpr (FIXMAX) {
                float ps = 0.f;
#pragma unroll
                for (int r = 0; r < 16; ++r) { s0[r] = __builtin_amdgcn_exp2f(s0[r]); s1[r] = __builtin_amdgcn_exp2f(s1[r]); ps += s0[r] + s1[r]; }
                l_run += ps;
            } else {
            float mx = fmaxf(s0[0], s1[0]);
#pragma unroll
            for (int r = 1; r < 16; ++r) mx = fmaxf(mx, fmaxf(s0[r], s1[r]));
            mx = fmaxf(mx, shflx(mx, 32));
            const float m_new = fmaxf(m_run, mx), alpha = __builtin_amdgcn_exp2f(m_run - m_new);
            float ps = 0.f;
#pragma unroll
            for (int r = 0; r < 16; ++r) { s0[r] = __builtin_amdgcn_exp2f(s0[r] - m_new); s1[r] = __builtin_amdgcn_exp2f(s1[r] - m_new); ps += s0[r] + s1[r]; }
            l_run = l_run * alpha + ps; m_run = m_new;
            if (__any(alpha != 1.0f)) {
#pragma unroll
                for (int db = 0; db < NDB; ++db)
#pragma unroll
                    for (int r = 0; r < 16; ++r) o[db][r] *= alpha;
            }
            }
            bf16x8 pf[4];
#pragma unroll
            for (int ks = 0; ks < 4; ++ks) { const f32x16& sx = (ks < 2) ? s0 : s1; const int b = (ks & 1) * 8; v4u w;
                w.x = cvt_pk_bf16(sx[b + 0], sx[b + 1]); w.y = cvt_pk_bf16(sx[b + 2], sx[b + 3]); w.z = cvt_pk_bf16(sx[b + 4], sx[b + 5]); w.w = cvt_pk_bf16(sx[b + 6], sx[b + 7]); pf[ks] = __builtin_bit_cast(bf16x8, w); }
            __builtin_amdgcn_sched_barrier(0);
#pragma unroll
            for (int i = 0; i < 4 * NDB; ++i) {
                if (i + 3 < 4 * NDB) ring[(i + 3) & 3] = AT_VFRAG(i + 3);
                o[i >> 2] = __builtin_amdgcn_mfma_f32_32x32x16_bf16(ring[i & 3], pf[i & 3], o[i >> 2], 0, 0, 0);
                __builtin_amdgcn_sched_barrier(0);
            }
#undef AT_KFRAG
#undef AT_VFRAG
        }
        if (more) {
            LAS unsigned char* nb = lds + ((t + 1) & 1) * BUF; int t_ = tid; asm volatile("" : "+v"(t_));
#pragma unroll
            for (int i = 0; i < NKC; ++i) *(LAS v4u*)(nb + AT_KL(t_, i)) = sk[i];
#pragma unroll
            for (int i = 0; i < NVC; ++i) *(LAS v4u*)(nb + AT_VL(t_, i)) = sv[i];
        }
        __syncthreads();
    }
    const float inv = (OUT8 ? 16.0f : 1.0f) / (l_run + shflx(l_run, 32));
    const bf16* gp = GOp + (size_t)(wave * 32 + r32) * 4096 + 4 * hi; bf16* op = OCp + (size_t)(wave * 32 + r32) * 4096 + 4 * hi;
#pragma unroll
    for (int db = 0; db < NDB; ++db)
#pragma unroll
        for (int g = 0; g < 4; ++g) { const bf16* p = gp + 32 * db + 8 * g; const v2u gv = *(const v2u*)p;
            const float y0 = o[db][4 * g + 0] * inv * bf_lo(gv.x), y1 = o[db][4 * g + 1] * inv * bf_hi(gv.x), y2 = o[db][4 * g + 2] * inv * bf_lo(gv.y), y3 = o[db][4 * g + 3] * inv * bf_hi(gv.y);
            if constexpr (OUT8) { float c0 = y0, c1 = y1, c2 = y2, c3 = y3;
                asm("v_min_f32 %0, 0x43e00000, %0\n\tv_max_f32 %0, 0xc3e00000, %0\n\tv_min_f32 %1, 0x43e00000, %1\n\tv_max_f32 %1, 0xc3e00000, %1\n\tv_min_f32 %2, 0x43e00000, %2\n\tv_max_f32 %2, 0xc3e00000, %2\n\tv_min_f32 %3, 0x43e00000, %3\n\tv_max_f32 %3, 0xc3e00000, %3" : "+v"(c0), "+v"(c1), "+v"(c2), "+v"(c3));
                int pk = __builtin_amdgcn_cvt_pk_fp8_f32(c0, c1, 0, false); pk = __builtin_amdgcn_cvt_pk_fp8_f32(c2, c3, pk, true);
                *(unsigned*)((unsigned char*)OCp + (size_t)(wave * 32 + r32) * 8192 + 4 * hi + 32 * db + 8 * g) = (unsigned)pk; }
            else { v2u w; w.x = cvt_pk_bf16(y0, y1); w.y = cvt_pk_bf16(y2, y3); *(v2u*)(op + 32 * db + 8 * g) = w; } }
#undef AT_KL
#undef AT_VL
}

__device__ __forceinline__ void attn_unit8(const unsigned char* Qp, const unsigned char* Kp, const unsigned char* VTp, int vpitch, int NT, int cw, bool rev, const bf16* GOp, bf16* OCp, LAS unsigned char* lds, int tid_in) {
    int tid = tid_in; asm volatile("" : "+v"(tid));
    constexpr int KP = 208, VP = 80, VOFF = 64 * KP, BUF = VOFF + 128 * VP;
    static_assert(2 * BUF <= RING_BYTES, "attention LDS image");
    const int lane = tid & 63, wave = __builtin_amdgcn_readfirstlane(tid >> 6), r32 = lane & 31, hi = lane >> 5;
    typedef int i32x4_ __attribute__((ext_vector_type(4))); typedef int i32x8_ __attribute__((ext_vector_type(8)));
#define AT8_LD(p_) __builtin_shufflevector(*(const LAS i32x4_*)(p_), *(const LAS i32x4_*)((p_) + 16), 0, 1, 2, 3, 4, 5, 6, 7)
    i32x8_ qf[3];
#pragma unroll
    for (int kk = 0; kk < 3; ++kk) { const i32x4_* qp = (const i32x4_*)(Qp + (size_t)(wave * 32 + r32) * 192 + 64 * kk + 32 * hi); qf[kk] = __builtin_shufflevector(qp[0], qp[1], 0, 1, 2, 3, 4, 5, 6, 7); }
    f32x16 o[4];
#pragma unroll
    for (int db = 0; db < 4; ++db)
#pragma unroll
        for (int r = 0; r < 16; ++r) o[db][r] = 0.f;
    float off = 0.f, l_run = 0.f;
    const unsigned ko = 16u * (unsigned)tid, vo = 16u * (unsigned)tid;
#define AT8_KL(c_) (((c_) / 12) * KP + ((c_) % 12) * 16)
#define AT8_VL(t_) (VOFF + ((t_) >> 2) * VP + ((t_) & 3) * 16)
    const int kfo = r32 * KP + 32 * hi, vfo = VOFF + r32 * VP + 32 * hi;
    const int kl0 = AT8_KL(tid), kl1 = AT8_KL(tid + 512), vl0 = AT8_VL(tid); const bool two = tid < 256;
    v4u sk0, sk1 = {0u, 0u, 0u, 0u}, sv;
    { const int tt0 = rev ? NT - 1 : 0; const unsigned char* kt = Kp + (size_t)tt0 * 12288; const unsigned char* vt = VTp + (size_t)tt0 * 8192;
      sk0 = *(const v4u*)(kt + ko); if (two) sk1 = *(const v4u*)(kt + 8192 + ko); sv = *(const v4u*)(vt + vo); }
    *(LAS v4u*)(lds + kl0) = sk0; if (two) *(LAS v4u*)(lds + kl1) = sk1; *(LAS v4u*)(lds + vl0) = sv;
    __syncthreads();
    for (int t = 0; t < NT; ++t) {
        const bool more = (t + 1 < NT);
        const int tt = rev ? NT - 1 - t : t;
        if (more) { const int tn = rev ? tt - 1 : tt + 1;
            const unsigned char* kt = Kp + (size_t)tn * 12288; const unsigned char* vt = VTp + (size_t)tn * 8192;
            sk0 = *(const v4u*)(kt + ko); if (two) sk1 = *(const v4u*)(kt + 8192 + ko); sv = *(const v4u*)(vt + vo); }
        if (tt <= cw) {
            LAS unsigned char* buf = lds + (t & 1) * BUF;
            f32x16 s0, s1;
#pragma unroll
            for (int r = 0; r < 16; ++r) { s0[r] = 0.f; s1[r] = 0.f; }
#define AT8_KFRAG(i) AT8_LD(buf + kfo + ((i) & 1) * 32 * KP + 64 * ((i) >> 1))
#define AT8_VFRAG(i) AT8_LD(buf + vfo + 32 * (i) * VP)
            i32x8_ ring[3];
            ring[0] = AT8_KFRAG(0); ring[1] = AT8_KFRAG(1);
            __builtin_amdgcn_sched_barrier(0);
#pragma unroll
            for (int i = 0; i < 6; ++i) {
                if (i + 2 < 6) ring[(i + 2) % 3] = AT8_KFRAG(i + 2);
                if (i & 1) s1 = __builtin_amdgcn_mfma_scale_f32_32x32x64_f8f6f4(ring[i % 3], qf[i >> 1], s1, 0, 0, 0, 0, 0, 0); else s0 = __builtin_amdgcn_mfma_scale_f32_32x32x64_f8f6f4(ring[i % 3], qf[i >> 1], s0, 0, 0, 0, 0, 0, 0);
                __builtin_amdgcn_sched_barrier(0);
            }
            ring[0] = AT8_VFRAG(0); ring[1] = AT8_VFRAG(1);
            if (__any(off != 0.f)) {
#pragma unroll
                for (int r = 0; r < 16; ++r) { s0[r] += off; s1[r] += off; } }
            float mx;
            asm("v_max3_f32 %0, %1, %2, %3" : "=v"(mx) : "v"(s0[0]), "v"(s0[1]), "v"(s0[2]));
#pragma unroll
            for (int r = 3; r < 15; r += 2) asm("v_max3_f32 %0, %0, %1, %2" : "+v"(mx) : "v"(s0[r]), "v"(s0[r + 1]));
            asm("s_nop 7\n\ts_nop 7\n\tv_max3_f32 %0, %0, %1, %2" : "+v"(mx) : "v"(s0[15]), "v"(s1[0]));
#pragma unroll
            for (int r = 1; r < 15; r += 2) asm("v_max3_f32 %0, %0, %1, %2" : "+v"(mx) : "v"(s1[r]), "v"(s1[r + 1]));
            { const float mo = shflx(mx, 32); asm("v_max3_f32 %0, %0, %1, %2" : "+v"(mx) : "v"(s1[15]), "v"(mo)); }
            if (__any(mx > 8.0f || mx < -2.0f)) {
                const float d = (mx > 8.0f || mx < -2.0f) ? mx - 4.0f : 0.f, alpha = __builtin_amdgcn_exp2f(-d);
                off -= d; l_run *= alpha;
#pragma unroll
                for (int r = 0; r < 16; ++r) { s0[r] -= d; s1[r] -= d; }
#pragma unroll
                for (int db = 0; db < 4; ++db)
#pragma unroll
                    for (int r = 0; r < 16; ++r) o[db][r] *= alpha;
            }
            float ps = 0.f;
#pragma unroll
            for (int r = 0; r < 16; ++r) { s0[r] = __builtin_amdgcn_exp2f(s0[r]); s1[r] = __builtin_amdgcn_exp2f(s1[r]); ps += s0[r] + s1[r]; }
            l_run += ps;
            i32x8_ pf;
#pragma unroll
            for (int j = 0; j < 8; ++j) { const f32x16& sx = (j < 4) ? s0 : s1; const int b = 4 * (j & 3); pf[j] = (int)pk_fp8x4(sx[b + 0], sx[b + 1], sx[b + 2], sx[b + 3]); }
            __builtin_amdgcn_sched_barrier(0);
#pragma unroll
            for (int i = 0; i < 4; ++i) {
                if (i + 2 < 4) ring[(i + 2) % 3] = AT8_VFRAG(i + 2);
                o[i] = __builtin_amdgcn_mfma_scale_f32_32x32x64_f8f6f4(ring[i % 3], pf, o[i], 0, 0, 0, 0, 0, 0);
                __builtin_amdgcn_sched_barrier(0);
            }
#undef AT8_KFRAG
#undef AT8_VFRAG
        }
        if (more) {
            LAS unsigned char* nb = lds + ((t + 1) & 1) * BUF;
            *(LAS v4u*)(nb + kl0) = sk0; if (two) *(LAS v4u*)(nb + kl1) = sk1; *(LAS v4u*)(nb + vl0) = sv;
        }
        __syncthreads();
    }
    const float inv = 16.0f / (l_run + shflx(l_run, 32));
    const bf16* gp = GOp + (size_t)(wave * 32 + r32) * 4096 + 4 * hi;
#pragma unroll
    for (int db = 0; db < 4; ++db)
#pragma unroll
        for (int g = 0; g < 4; ++g) { const bf16* p = gp + 32 * db + 8 * g; const v2u gv = *(const v2u*)p;
            float c0 = o[db][4 * g + 0] * inv * bf_lo(gv.x), c1 = o[db][4 * g + 1] * inv * bf_hi(gv.x), c2 = o[db][4 * g + 2] * inv * bf_lo(gv.y), c3 = o[db][4 * g + 3] * inv * bf_hi(gv.y);
            asm("v_min_f32 %0, 0x43e00000, %0\n\tv_max_f32 %0, 0xc3e00000, %0\n\tv_min_f32 %1, 0x43e00000, %1\n\tv_max_f32 %1, 0xc3e00000, %1\n\tv_min_f32 %2, 0x43e00000, %2\n\tv_max_f32 %2, 0xc3e00000, %2\n\tv_min_f32 %3, 0x43e00000, %3\n\tv_max_f32 %3, 0xc3e00000, %3" : "+v"(c0), "+v"(c1), "+v"(c2), "+v"(c3));
            *(unsigned*)((unsigned char*)OCp + (size_t)(wave * 32 + r32) * 8192 + 4 * hi + 32 * db + 8 * g) = pk_fp8x4(c0, c1, c2, c3); }
#undef AT8_KL
#undef AT8_VL
#undef AT8_LD
}

__device__ __forceinline__ void sb_wave(const bf16* QKV, const bf16* KFbh, const bf16* VFbh, size_t rowbase, int h, int q0, const bf16* GO, bf16* OC, int lane) {
    const int r32 = lane & 31, hi = lane >> 5;
    bf16x8 qf[8];
    const bf16* qp = QKV + (rowbase + q0 + r32) * 3072 + h * 128 + 8 * hi;
#pragma unroll
    for (int kk = 0; kk < 8; ++kk) qf[kk] = *(const bf16x8*)(qp + 16 * kk);
    f32x16 o[4];
#pragma unroll
    for (int db = 0; db < 4; ++db)
#pragma unroll
        for (int r = 0; r < 16; ++r) o[db][r] = 0.f;
    float R = 0.f;
    const int tq = q0 + r32;
    const float scale = 0.08838834764831845f;
    const float LN2 = 0.6931471805599453f;
    for (int key0 = q0; key0 >= 0; key0 -= 32) {
        f32x16 s;
#pragma unroll
        for (int r = 0; r < 16; ++r) s[r] = 0.f;
        const bf16* kp = KFbh + ((size_t)(key0 >> 5) * 8 * 64 + lane) * 8;
#pragma unroll
        for (int kk = 0; kk < 8; ++kk) { const bf16x8 a = *(const bf16x8*)(kp + kk * 512); s = __builtin_amdgcn_mfma_f32_32x32x16_bf16(a, qf[kk], s, 0, 0, 0); }
        float lf[16], lb[16]; float T0 = 0.f, T1 = 0.f;
#pragma unroll
        for (int r = 0; r < 16; ++r) { const int key = key0 + 16 * (r >> 3) + 8 * hi + (r & 7); const bool valid = key < tq;
            const float z = s[r] * scale; const float sp = __builtin_amdgcn_logf(1.0f + __builtin_amdgcn_exp2f(-fabsf(z) * LOG2E)) * LN2;
            lb[r] = valid ? (fminf(z, 0.f) - sp) : -INFINITY;
            lf[r] = valid ? (-fmaxf(z, 0.f) - sp) : 0.f;
            if (r < 8) T0 += lf[r]; else T1 += lf[r]; }
        const float PT0 = shflx(T0, 32), PT1 = shflx(T1, 32);
        float a0 = R + (hi == 0 ? (PT0 + T1 + PT1) : (PT1 + T1));
        float a1 = R + (hi == 0 ? PT1 : 0.f);
        float w[16];
#pragma unroll
        for (int r = 7; r >= 0; --r) { w[r] = __builtin_amdgcn_exp2f((lb[r] + a0) * LOG2E); a0 += lf[r]; }
#pragma unroll
        for (int r = 15; r >= 8; --r) { w[r] = __builtin_amdgcn_exp2f((lb[r] + a1) * LOG2E); a1 += lf[r]; }
        const float own = T0 + T1; R += own + shflx(own, 32);
        bf16x8 pf[2];
#pragma unroll
        for (int ks = 0; ks < 2; ++ks) { const int b = ks * 8; v4u pw; pw.x = cvt_pk_bf16(w[b + 0], w[b + 1]); pw.y = cvt_pk_bf16(w[b + 2], w[b + 3]); pw.z = cvt_pk_bf16(w[b + 4], w[b + 5]); pw.w = cvt_pk_bf16(w[b + 6], w[b + 7]); pf[ks] = __builtin_bit_cast(bf16x8, pw); }
        const bf16* vp = VFbh + ((size_t)(key0 >> 5) * 8 * 64 + lane) * 8;
#pragma unroll
        for (int db = 0; db < 4; ++db)
#pragma unroll
            for (int ks = 0; ks < 2; ++ks) { const bf16x8 vf = *(const bf16x8*)(vp + (db * 2 + ks) * 512); o[db] = __builtin_amdgcn_mfma_f32_32x32x16_bf16(vf, pf[ks], o[db], 0, 0, 0); }
        if (__all(R < -104.0f)) break;
    }
    const bf16* gp = GO + (rowbase + q0 + r32) * 4096 + 2048 + h * 128 + 4 * hi; bf16* op = OC + (rowbase + q0 + r32) * 4096 + 2048 + h * 128 + 4 * hi;
#pragma unroll
    for (int db = 0; db < 4; ++db)
#pragma unroll
        for (int g = 0; g < 4; ++g) { const bf16* p = gp + 32 * db + 8 * g; const v2u gv = *(const v2u*)p; v2u ww;
            ww.x = cvt_pk_bf16(o[db][4 * g + 0] * bf_lo(gv.x), o[db][4 * g + 1] * bf_hi(gv.x)); ww.y = cvt_pk_bf16(o[db][4 * g + 2] * bf_lo(gv.y), o[db][4 * g + 3] * bf_hi(gv.y));
            *(v2u*)(op + 32 * db + 8 * g) = ww; }
}

struct Args { const float* in[19]; float* out; unsigned char* ws; int s_lo, s_hi; };
enum { I_X = 0, I_MEM, I_POS, I_GPRE, I_WIN, I_GQLAT, I_WUQ, I_GKVLAT, I_WUKV, I_GQNA, I_GKNA, I_WPA, I_WPB, I_GMEM, I_WMKV, I_GQNM, I_GKNM, I_WPM, I_WOUT };
constexpr int NSTEPS = 3 + 8 * DEPTH;

__global__ void __launch_bounds__(NTHREADS, 2) fwd_kernel(Args args) {
    extern __shared__ __attribute__((aligned(16))) unsigned char lds_raw[];
    LAS unsigned char* lds = (LAS unsigned char*)lds_raw;
    volatile LAS unsigned* MISC = (volatile LAS unsigned*)(lds + MISC_OFF);
    const int tid0 = threadIdx.x, lane0 = tid0 & 63, wave = __builtin_amdgcn_readfirstlane(tid0 >> 6);
#define PHASE_LANE int tid = (wave << 6) | fresh_lane(); asm volatile("" : "+v"(tid));     const int lane = tid & 63; (void)lane; unsigned char* ws = ws_g; int bx = bx_g; asm volatile("" : "+s"(ws), "+s"(bx));
    const int G = gridDim.x; const int bx_g = blockIdx.x; const int vcu = (G % 8 == 0) ? (bx_g % 8) * (G / 8) + bx_g / 8 : bx_g;
    const int gw = vcu * NWAVES + wave, NGW = G * NWAVES;
    unsigned char* const ws_g = args.ws; unsigned char* ws = ws_g;
    for (int u = tid0; u < (LDS_BYTES - RING_BYTES) / 4; u += NTHREADS) ((LAS unsigned*)(lds + RING_BYTES))[u] = 0u;
    __syncthreads();
    XcdBarrier bar = xcd_barrier_post((unsigned*)(ws + WS_CTL) + CW_BAR, MISC + 8, wave);
    const int lo = args.s_lo, hi_ = args.s_hi;
#ifndef STEP_MASK
#define STEP_MASK 0x7ff
#endif
#define EN(b) (((STEP_MASK) >> (b)) & 1)
#ifndef REP_STEP
#define REP_STEP (-1)
#define REP_COUNT 1
#endif
#define REPS(k) ((k) == REP_STEP ? REP_COUNT : 1)
#define IN(k) (lo <= (k) && (k) < hi_)
#define SEAM(k) do { if ((k) + 1 < hi_) xcd_barrier(bar); } while (0)

    const float* x_in = args.in[I_X];
    float* out = args.out;
#define Hb ((bf16*)(ws + WS_H))
#define CQ ((bf16*)(ws + WS_CQ))
#define CKV ((bf16*)(ws + WS_CKV))
#define KR ((bf16*)(ws + WS_KR))
#define GO ((bf16*)(ws + WS_GO))
#define QKVB ((bf16*)(ws + WS_QKVB))
#define QM ((bf16*)(ws + WS_QM))
#define Rg ((bf16*)(ws + WS_R))
#define QAR ((bf16*)(ws + WS_QAR))
#define KVA ((bf16*)(ws + WS_KVA))
#define QA ((bf16*)(ws + WS_QA))
#define KA ((bf16*)(ws + WS_KA))
#define VTA ((bf16*)(ws + WS_VTA))
#define VTB ((bf16*)(ws + WS_VTB))
#define KFB ((bf16*)(ws + WS_KA + (size_t)M * 3072))
#define QMN ((bf16*)(ws + WS_QMN))
#define OC ((bf16*)(ws + WS_OC))
#define XA ((float*)(ws + WS_XA))
#define H8 ((unsigned char*)(ws + WS_H8))
#define MIXB ((bf16*)(ws + WS_MIXB))
#define MEMN ((bf16*)(ws + WS_MEMN))
#define KVM ((bf16*)(ws + WS_KVM))
#define KM ((bf16*)(ws + WS_KM))
#define VTM ((bf16*)(ws + WS_VTM))
#define ROPC ((float*)(ws + WS_ROPE))
#define ROPS (ROPC + (size_t)M * 32)
#define SSQX ((pg8::ssq_t*)(ws + WS_CTL + CTL_SSQX))
#define SSQQ ((pg8::ssq_t*)(ws + WS_CTL + CTL_SSQQ))
#define SSQK ((pg8::ssq_t*)(ws + WS_CTL + CTL_SSQK))
    if (EN(0) && IN(0)) { PHASE_LANE for (int rep_ = 0; rep_ < REPS(0); ++rep_) {
        LAS float* scr = (LAS float*)(lds + wave * 16384);
        constexpr int IT_IN = 64 * (NIN / 32), IT_UQ = 16 * 96, IT_UKV = 8 * 128, IT_PA = 32 * 128, IT_PB = 16 * 128, IT_PM = 16 * 128, IT_MKV = 64 * 64, IT_OUT = 64 * 128;
        constexpr int IT_LAYER = IT_IN + IT_UQ + IT_UKV + IT_PA + IT_PB + IT_PM + IT_MKV + IT_OUT;
#define TR_DECODE(it_, D) do { const int l = (it_) / IT_LAYER; int r = (it_) % IT_LAYER; unsigned char* wl_ = ws + WS_W + (size_t)l * WL_STRIDE; \
            if (r < IT_IN) { const int nb = NIN / 32, kb = r / nb, n0 = 32 * (r % nb); \
                if (n0 >= 9792 || n0 < 3648) D = TrDesc{args.in[I_WIN] + (size_t)l * 4096 * NIN, args.in[I_GPRE] + l * 4096, (bf16*)(wl_ + WL_W8), (n0 >= 9792) ? (size_t)(n0 - 9792) : (n0 < 1536 ? (size_t)(12288 + n0) : (n0 < 1600 ? (size_t)(15872 + n0 - 1536) : (size_t)(13824 + n0 - 1600))), NIN, 64 * kb, n0, 4096, 0, 1}; \
                else D = TrDesc{args.in[I_WIN] + (size_t)l * 4096 * NIN, args.in[I_GPRE] + l * 4096, (bf16*)(wl_ + WL_WIN), (size_t)(n0 - 3648), NIN, 64 * kb, n0, 4096, 0, 0}; break; } r -= IT_IN; \
            if (r < IT_UQ) { const int nb = 96, kb = r / nb, n0 = 32 * (r % nb); D = TrDesc{args.in[I_WUQ] + (size_t)l * 1024 * 3072, args.in[I_GQLAT] + l * 1024, (bf16*)(wl_ + WL_WUQ), (size_t)n0, 3072, 64 * kb, n0, 1024, 0, 1}; break; } r -= IT_UQ; \
            if (r < IT_UKV) { const int nb = 128, kb = r / nb, n0 = 32 * (r % nb); D = TrDesc{args.in[I_WUKV] + (size_t)l * 512 * 4096, args.in[I_GKVLAT] + l * 512, (bf16*)(wl_ + WL_WUKV), (size_t)n0, 4096, 64 * kb, n0, 512, 0, 1}; break; } r -= IT_UKV; \
            if (r < IT_PA) { const int nb = 128, kb = r / nb, n0 = 32 * (r % nb); D = TrDesc{args.in[I_WPA] + (size_t)l * 2048 * 4096, nullptr, (bf16*)(wl_ + WL_WPROJ), (size_t)n0, 4096, 64 * kb, n0, 8192, 0, 1}; break; } r -= IT_PA; \
            if (r < IT_PB) { const int nb = 128, kb = r / nb, n0 = 32 * (r % nb); D = TrDesc{args.in[I_WPB] + (size_t)l * 1024 * 4096, nullptr, (bf16*)(wl_ + WL_WPROJ), (size_t)n0, 4096, 64 * kb, n0, 4096, 2048, 0}; break; } r -= IT_PB; \
            if (r < IT_PM) { const int nb = 128, kb = r / nb, n0 = 32 * (r % nb); D = TrDesc{args.in[I_WPM] + (size_t)l * 1024 * 4096, nullptr, (bf16*)(wl_ + WL_WPROJ), (size_t)n0, 4096, 64 * kb, n0, 4096, 3072, 0}; break; } r -= IT_PM; \
            if (r < IT_MKV) { const int nb = 64, kb = r / nb, n0 = 32 * (r % nb); D = TrDesc{args.in[I_WMKV] + (size_t)l * 4096 * 2048, args.in[I_GMEM] + l * 4096, (bf16*)(ws + WS_WMKV), (size_t)(l * 2048 + n0), 2048, 64 * kb, n0, 4096, 0, 0}; break; } r -= IT_MKV; \
            { const int nb = 128, kb = r / nb, n0 = 32 * (r % nb); D = TrDesc{args.in[I_WOUT] + (size_t)l * 4096 * 4096, nullptr, (bf16*)(wl_ + WL_WOUT), (size_t)n0, 4096, 64 * kb, n0, 4096, 0, 0}; } } while (0)
        if (gw < DEPTH * IT_LAYER) {
            TrDesc cur{}; f32x4 vc[8]; TR_DECODE(gw, cur); tr_load(cur, vc, lane);
            for (int it = gw; it < DEPTH * IT_LAYER; it += NGW) {
                TrDesc nx = cur; f32x4 vn[8]; const bool more = it + NGW < DEPTH * IT_LAYER;
                if (more) { TR_DECODE(it + NGW, nx); tr_load(nx, vn, lane); }
                tr_finish(cur, vc, scr, lane);
                if (more) { cur = nx;
#pragma unroll
                    for (int i = 0; i < 8; ++i) vc[i] = vn[i]; }
            }
        }
#undef TR_DECODE
        for (int it = gw; it < DEPTH * 192 * 4; it += NGW) { const int l = it / (192 * 4), rr = (it / 4) % 192, seg = it % 4;
            *(v4u*)(ws + WS_W + (size_t)l * WL_STRIDE + WL_W8 + (size_t)(15936 + rr) * 4096 + seg * 1024 + lane * 16) = (v4u){0u, 0u, 0u, 0u}; }
        for (int row = gw; row < BATCH * MEMLEN; row += NGW) {
            const f32x4* xr = (const f32x4*)(args.in[I_MEM] + (size_t)row * 4096) + lane; f32x4 v[16]; float s = 0.f;
#pragma unroll
            for (int j = 0; j < 16; ++j) { v[j] = xr[64 * j]; s += (v[j].x * v[j].x + v[j].y * v[j].y) + (v[j].z * v[j].z + v[j].w * v[j].w); }
            const float rstd = 1.0f / sqrtf(wave_sum(s) * (1.0f / 4096.0f) + EPS);
            v2u* o8 = (v2u*)(MEMN + (size_t)row * 4096) + lane;
#pragma unroll
            for (int j = 0; j < 16; ++j) { v2u w; w.x = cvt_pk_bf16(v[j].x * rstd, v[j].y * rstd); w.y = cvt_pk_bf16(v[j].z * rstd, v[j].w * rstd); o8[64 * j] = w; }
        }
        for (int row = gw; row < M; row += NGW) {
            const f32x4* xr = (const f32x4*)(x_in + (size_t)row * 4096) + lane; f32x4 v[16]; float sq = 0.f;
#pragma unroll
            for (int j = 0; j < 16; ++j) { v[j] = xr[64 * j]; sq += (v[j].x * v[j].x + v[j].y * v[j].y) + (v[j].z * v[j].z + v[j].w * v[j].w); }
            sq = wave_sum(sq); if (lane == 0) SSQX[row] = (pg8::ssq_t)__float2ull_rn(sq * pg8::SSQ_FIX);
            v2u* o8 = (v2u*)(Hb + (size_t)row * 4096) + lane;
#pragma unroll
            for (int j = 0; j < 16; ++j) { v2u w; w.x = cvt_pk_bf16(v[j].x, v[j].y); w.y = cvt_pk_bf16(v[j].z, v[j].w); o8[64 * j] = w; }
            unsigned* o4 = (unsigned*)(H8 + (size_t)row * 4096) + lane;
#pragma unroll
            for (int j = 0; j < 16; ++j) { int p = __builtin_amdgcn_cvt_pk_fp8_f32(v[j].x, v[j].y, 0, false); p = __builtin_amdgcn_cvt_pk_fp8_f32(v[j].z, v[j].w, p, true); o4[64 * j] = (unsigned)p; }
        }
        for (int idx = blockIdx.x * NTHREADS + tid; idx < M * 32; idx += G * NTHREADS) { const int row = idx >> 5, j = idx & 31;
            const float freq = (float)exp2(-(double)j * (13.287712379549449 / 32.0));
            const float ang = (float)((const int*)args.in[I_POS])[row] * freq;
            const double a = (double)ang; ROPC[idx] = (float)cos(a); ROPS[idx] = (float)sin(a); }
        } SEAM(0);
    }

    if (EN(1) && IN(1)) { PHASE_LANE (void)tid; for (int rep_ = 0; rep_ < REPS(1); ++rep_) {
        pg8::Gemm g{MEMN, (const bf16*)(ws + WS_WMKV), BATCH * MEMLEN, DEPTH * 2048, 4096}; pg8::TailOrder S{G, bx};
        pg8::EpiPlain E{KVM, DEPTH * 2048, nullptr};
        pg8::gemm_phase<pg8::EpiPlain, pg8::TailOrder, true, true>(lds, g, S, E, tid);
        }
    }

    for (int l = 0; l < DEPTH; ++l) {
        const int sb = 3 + 8 * l;
        unsigned char* wl = ws + WS_W + (size_t)l * WL_STRIDE;
        const float* xcur = (l == 0) ? x_in : ((l & 1) ? (const float*)XA : (const float*)out); float* xnext = (l & 1) ? out : XA;

        if (EN(4) && IN(sb + 1)) { PHASE_LANE for (int rep_ = 0; rep_ < REPS(4); ++rep_) {
            pg8::Gemm g{Hb, (const bf16*)(wl + WL_WIN), M, NB16, 4096}; pg8::StaticOrder S; S.init(M, NB16, G, bx);
            LAS float* rst = (LAS float*)(lds + RSTAB_OFF);
            { pg8::Unit u0{0, 0}; (void)S.next(0, u0); int pm0 = u0.pm; asm volatile("" : "+s"(pm0)); if (tid < 256) rst[tid] = __builtin_amdgcn_rsqf(pg8::ssq_get(SSQX + (size_t)l * M + pm0 * 256 + tid) * (1.0f / 4096.0f) + EPS); }
            __syncthreads();
            pg8::EpiIn<WsL> E{ws, rst};
            pg8::gemm_phase<pg8::EpiIn<WsL>, pg8::StaticOrder, true, true>(lds, g, S, E, tid);
            { pg8::Gemm g8{(const bf16*)H8, (const bf16*)(wl + WL_W8), M, NG8, 2048}; pg8::StaticOrder S8; S8.init(M, NG8, G, bx);
              pg8::EpiGate<WsL> E8{ws, rst, l * M};
              pg8::gemm_phase<pg8::EpiGate<WsL>, pg8::StaticOrder, true, true>(lds, g8, S8, E8, tid); }
            } SEAM(sb + 1);
        }

        if (EN(6) && IN(sb + 3)) { PHASE_LANE for (int rep_ = 0; rep_ < REPS(6); ++rep_) {
            LAS float* rst = (LAS float*)(lds + RSTAB_OFF);
            { pg8::StaticOrder S0; S0.init(M, 4096, G, bx); pg8::Unit u0;
              if (S0.next(0, u0) && tid < 256) { rst[tid] = __builtin_amdgcn_rsqf(pg8::ssq_get(SSQQ + (size_t)l * M + u0.pm * 256 + tid) * (1.0f / 1024.0f) + EPS) * (1.0f / 64.0f); rst[256 + tid] = __builtin_amdgcn_rsqf(pg8::ssq_get(SSQK + (size_t)l * M + u0.pm * 256 + tid) * (1.0f / 512.0f) + EPS) * (1.0f / 64.0f); } }
            __syncthreads();
            for (int j = 0; j < 2; ++j) {
                pg8::Gemm g = (j == 0) ? pg8::Gemm{CQ, (const bf16*)(wl + WL_WUQ), M, 3072, 512} : pg8::Gemm{CKV, (const bf16*)(wl + WL_WUKV), M, 4096, 256};
                pg8::StaticOrder S; S.init(M, g.N, G, bx);
                pg8::EpiPlainT<true> E{(j == 0) ? QAR : KVA, g.N, rst + 256 * j};
                pg8::gemm_phase<pg8::EpiPlainT<true>, pg8::StaticOrder, true, true>(lds, g, S, E, tid);
            }
            } SEAM(sb + 3);
        }

        if (EN(7) && IN(sb + 4)) { PHASE_LANE for (int rep_ = 0; rep_ < REPS(7); ++rep_) {
            LAS unsigned char* scr = lds + wave * 9216;
            const float* gqa = args.in[I_GQNA] + l * 192; const float* gka = args.in[I_GKNA] + l * 192; const float* gqm = args.in[I_GQNM] + l * 256;
            constexpr int N_A = 256 * 16, N_B = 256 * 16, N_C = 256 * 16 * 2, N_D = 256 * 8 * 2, N_E = 256 * 4, N_F = 2 * 4 * 4 * 5;
            const float QSC = 0.07216878364870322f * LOG2E;
            const float MSC = 0.0625f * LOG2E;
            for (int it = gw; it < N_A + N_B + N_C + N_D + N_E + N_F; it += NGW) {
                int r = it;
                if (r >= N_A + N_B + N_C + N_D + N_E) {
                    r -= N_A + N_B + N_C + N_D + N_E;
                    const int job = r % 5, kb = (r / 5) % 4, h = (r / 20) % 4, b = r / 80; const size_t lbh = ((size_t)l * 2 + b) * 4 + h;
                    if (job == 0) {
                        const bf16* src = KVM + (size_t)(b * 256 + kb * 64 + lane) * 8192 + l * 2048 + h * 256; float ss = 0.f;
#pragma unroll 4
                        for (int c = 0; c < 32; ++c) ss += ssq8(*(const v4u*)(src + 8 * c));
                        const float rstd = 1.0f / sqrtf(ss * (1.0f / 256.0f) + EPS);
                        const float* gk = args.in[I_GKNM] + l * 256; bf16* dst = KM + (lbh * 256 + kb * 64 + lane) * 256;
#pragma unroll 4
                        for (int c = 0; c < 32; ++c) { const v4u v = *(const v4u*)(src + 8 * c); v4u w;
#pragma unroll
                            for (int e = 0; e < 4; ++e) w[e] = cvt_pk_bf16(bf_lo(v[e]) * rstd * gk[8 * c + 2 * e], bf_hi(v[e]) * rstd * gk[8 * c + 2 * e + 1]);
                            *(v4u*)(dst + 8 * c) = w; }
                    } else { const int dq = job - 1;
                        transpose_64x64(KVM + (size_t)(b * 256 + kb * 64) * 8192 + l * 2048 + 1024 + h * 256 + dq * 64, 8192, VTM + (lbh * 256 + dq * 64) * 256 + kb * 64, 256, scr, lane); }
                    continue;
                }
                if (r < N_A + N_B) {
                    const bool isq = r < N_A; if (!isq) r -= N_A;
                    const int tb = r / 16, h = r % 16, p = lane & 7; const float* gv = isq ? gqa : gka;
                    float g0[8], g1[8], g2[8];
#pragma unroll
                    for (int e = 0; e < 8; ++e) { g0[e] = gv[8 * p + e]; g1[e] = gv[64 + 8 * p + e]; g2[e] = gv[128 + 8 * p + e]; }
                    for (int sub = 0; sub < 8; ++sub) {
                        const size_t row = (size_t)tb * 64 + sub * 8 + (lane >> 3); const int b = (int)(row / SEQ), s = (int)(row % SEQ);
                        const bf16* nope = isq ? QAR + row * 3072 + h * 192 : KVA + row * 4096 + h * 256;
                        const bf16* ropp = isq ? nope + 128 : KR + row * 64;
                        const v4u v0 = *(const v4u*)(nope + 8 * p), v1 = *(const v4u*)(nope + 64 + 8 * p), v2 = *(const v4u*)(ropp + 8 * p);
                        const f32x4 c0 = *(const f32x4*)(ROPC + row * 32 + 8 * (p & 3)), c1 = *(const f32x4*)(ROPC + row * 32 + 8 * (p & 3) + 4);
                        const f32x4 n0 = *(const f32x4*)(ROPS + row * 32 + 8 * (p & 3)), n1 = *(const f32x4*)(ROPS + row * 32 + 8 * (p & 3) + 4);
                        float ss = ssq8(v0) + ssq8(v1) + ssq8(v2);
                        ss += shflx(ss, 1); ss += shflx(ss, 2); ss += shflx(ss, 4);
                        const float sc = (1.0f / sqrtf(ss * (1.0f / 192.0f) + EPS)) * (isq ? 4.0f * QSC : 0.25f);
                        unsigned char* dst = (unsigned char*)(isq ? QA : KA) + (((size_t)b * 16 + h) * SEQ + s) * 192;
                        float f0[8], f1[8];
#pragma unroll
                        for (int e = 0; e < 4; ++e) { f0[2 * e] = bf_lo(v0[e]) * sc * g0[2 * e]; f0[2 * e + 1] = bf_hi(v0[e]) * sc * g0[2 * e + 1]; f1[2 * e] = bf_lo(v1[e]) * sc * g1[2 * e]; f1[2 * e + 1] = bf_hi(v1[e]) * sc * g1[2 * e + 1]; }
                        float xo[8], xp[8];
#pragma unroll
                        for (int e = 0; e < 4; ++e) { xo[2 * e] = bf_lo(v2[e]) * sc * g2[2 * e]; xo[2 * e + 1] = bf_hi(v2[e]) * sc * g2[2 * e + 1]; }
#pragma unroll
                        for (int e = 0; e < 8; ++e) xp[e] = shflx(xo[e], 4);
                        const float sgn = (p < 4) ? -1.0f : 1.0f; float ro[8];
#pragma unroll
                        for (int e = 0; e < 8; ++e) { const float c_ = (e < 4) ? c0[e] : c1[e - 4], s_ = (e < 4) ? n0[e] : n1[e - 4]; ro[e] = xo[e] * c_ + sgn * xp[e] * s_; }
                        *(v2u*)(dst + 8 * p) = (v2u){pk_fp8x4(f0[0], f0[1], f0[2], f0[3]), pk_fp8x4(f0[4], f0[5], f0[6], f0[7])};
                        *(v2u*)(dst + 64 + 8 * p) = (v2u){pk_fp8x4(f1[0], f1[1], f1[2], f1[3]), pk_fp8x4(f1[4], f1[5], f1[6], f1[7])};
                        *(v2u*)(dst + 128 + 8 * p) = (v2u){pk_fp8x4(ro[0], ro[1], ro[2], ro[3]), pk_fp8x4(ro[4], ro[5], ro[6], ro[7])};
                    }
                    continue;
                }
                r -= N_A + N_B;
                if (r < N_C) {
                    const int dh = r & 1, h = (r >> 1) % 16, tb = r / 32; const int b = (tb * 64) / SEQ, s0 = (tb * 64) % SEQ;
                    transpose_64x64_f8(KVA + (size_t)tb * 64 * 4096 + h * 256 + 128 + dh * 64, 4096, (unsigned char*)VTA + ((((size_t)b * 16 + h) * 128 + (s0 >> 6)) * 128 + dh * 64) * 64, 64, scr, lane); continue; }
                r -= N_C;
                if (r < N_D) {
                    const int dh = r & 1, h = (r >> 1) % 8, tb = r / 16; const int b = (tb * 64) / SEQ, s0 = (tb * 64) % SEQ;
                    transpose_64x64_frag(QKVB + (size_t)tb * 64 * 3072 + 2048 + h * 128 + dh * 64, 3072, VTB + ((size_t)b * 8 + h) * 128 * SEQ, s0 >> 5, dh, scr, lane); continue; }
                r -= N_D;
                {
                    const int tb = r / 4, h = r % 4, p = lane & 7;
                    float g[4][8];
#pragma unroll
                    for (int k = 0; k < 4; ++k)
#pragma unroll
                        for (int e = 0; e < 8; ++e) g[k][e] = gqm[64 * k + 8 * p + e];
                    for (int sub = 0; sub < 8; ++sub) {
                        const size_t row = (size_t)tb * 64 + sub * 8 + (lane >> 3); const int b = (int)(row / SEQ), s = (int)(row % SEQ);
                        const bf16* src = QM + row * 1024 + h * 256 + 8 * p; v4u v[4]; float ss = 0.f;
#pragma unroll
                        for (int k = 0; k < 4; ++k) { v[k] = *(const v4u*)(src + 64 * k); ss += ssq8(v[k]); }
                        ss += shflx(ss, 1); ss += shflx(ss, 2); ss += shflx(ss, 4);
                        const float sc = (1.0f / sqrtf(ss * (1.0f / 256.0f) + EPS)) * MSC;
                        bf16* dst = QMN + (((size_t)b * 4 + h) * SEQ + s) * 256 + 8 * p;
#pragma unroll
                        for (int k = 0; k < 4; ++k) { v4u w;
#pragma unroll
                            for (int e = 0; e < 4; ++e) w[e] = cvt_pk_bf16(bf_lo(v[k][e]) * sc * g[k][2 * e], bf_hi(v[k][e]) * sc * g[k][2 * e + 1]);
                            *(v4u*)(dst + 64 * k) = w; }
                    }
                }
            }
            } SEAM(sb + 4);
        }

        if (EN(8) && IN(sb + 5)) { PHASE_LANE for (int rep_ = 0; rep_ < REPS(8); ++rep_) {
            bool fixM;
            { float c = 0.f, d = 0.f;
              for (int i = 0; i < 256; ++i) { c = fmaxf(c, fabsf(args.in[I_GQNM][l * 256 + i])); d = fmaxf(d, fabsf(args.in[I_GKNM][l * 256 + i])); }
              fixM = 16.0f * LOG2E * 1.05f * c * d <= 96.0f; }
            for (int ua = vcu; ua < BATCH * 16 * 8; ua += G) { const int bh = ua >> 3, s = ua & 7, b = bh >> 4, h = bh & 15;
                for (int i = 0; i < 4; ++i) { const int qb = (i == 0) ? s : (i == 1) ? 15 - s : (i == 2) ? 16 + s : 31 - s; const size_t go = ((size_t)b * SEQ + qb * 256) * 4096 + h * 128;
                    bf16* const oc8 = (bf16*)((unsigned char*)OC + ((size_t)b * SEQ + qb * 256) * 8192 + h * 128);
                    attn_unit8((const unsigned char*)QA + ((size_t)bh * SEQ + qb * 256) * 192, (const unsigned char*)KA + (size_t)bh * SEQ * 192, (const unsigned char*)VTA + (size_t)bh * 128 * SEQ, SEQ, 4 * qb + 4, 4 * qb + (wave >> 1), (i & 1) != 0, GO + go, oc8, lds, tid); } }
            int tidm = tid; asm volatile("" : "+v"(tidm));
            for (int um = vcu; um < BATCH * 4 * 32; um += G) { const int bh = um >> 5, qb = um & 31, b = bh >> 2, h = bh & 3; const size_t lbh = ((size_t)l * 2 + b) * 4 + h;
                if (fixM) {
                    for (int pass = 0; pass < 2; ++pass) { const size_t go = ((size_t)b * SEQ + qb * 256) * 4096 + 3072 + h * 256 + pass * 128;
                        attn_unit<256, 4, true>(QMN + ((size_t)bh * SEQ + qb * 256) * 256, KM + lbh * 256 * 256, VTM + (lbh * 256 + pass * 128) * 256, 256, 4, 4, false, GO + go, OC + go, lds, tidm); }
                } else {
                    for (int pass = 0; pass < 4; ++pass) { const size_t go = ((size_t)b * SEQ + qb * 256) * 4096 + 3072 + h * 256 + pass * 64;
                        attn_unit<256, 2, false>(QMN + ((size_t)bh * SEQ + qb * 256) * 256, KM + lbh * 256 * 256, VTM + (lbh * 256 + pass * 64) * 256, 256, 4, 4, false, GO + go, OC + go, lds, tidm); }
                } }
            for (int u = gw; u < BATCH * 8 * 256; u += NGW) { const int bh = u >> 8, qb = u & 255; const int b = bh >> 3, h = bh & 7;
                sb_wave(QKVB, KFB + (size_t)bh * 128 * SEQ, VTB + (size_t)bh * 128 * SEQ, (size_t)b * SEQ, h, 32 * qb, GO, OC, lane); }
            } SEAM(sb + 5);
        }

        if (EN(9) && IN(sb + 6)) { PHASE_LANE for (int rep_ = 0; rep_ < REPS(9); ++rep_) {
            pg8::Gemm g{OC, (const bf16*)(wl + WL_WPROJ), M, 4096, 48 * 64, 4096}; pg8::StaticOrder S; S.init(M, 4096, G, bx);
            pg8::EpiProj E{Rg, MIXB};
            pg8::gemm_phase<pg8::EpiProj, pg8::StaticOrder, true, true>(lds, g, S, E, tid);
            } SEAM(sb + 6);
        }

        if (EN(10) && IN(sb + 7)) { PHASE_LANE for (int rep_ = 0; rep_ < REPS(10); ++rep_) {
            pg8::Gemm g{MIXB, (const bf16*)(wl + WL_WOUT), M, 4096, 4096}; pg8::StaticOrder S; S.init(M, 4096, G, bx);
            pg8::EpiOut E{xcur, xnext, (l + 1 < DEPTH) ? Hb : nullptr, H8, SSQX + (size_t)((l + 1 < DEPTH) ? l + 1 : 0) * M};
            pg8::gemm_phase<pg8::EpiOut, pg8::StaticOrder, true, true>(lds, g, S, E, tid);
            } SEAM(sb + 7);
        }
    }
#undef IN
#undef SEAM
#undef Hb
#undef CQ
#undef CKV
#undef KR
#undef GO
#undef QKVB
#undef QM
#undef Rg
#undef QAR
#undef KVA
#undef QA
#undef KA
#undef VTA
#undef VTB
#undef KFB
#undef QMN
#undef OC
#undef XA
#undef H8
#undef MIXB
#undef MEMN
#undef KVM
#undef KM
#undef VTM
#undef ROPC
#undef ROPS
#undef SSQX
#undef SSQQ
#undef SSQK
}

#ifndef MK_LAUNCH_PER_STEP
#define MK_LAUNCH_PER_STEP 0
#endif
extern "C" void kernel_launch(void* const* d_in, const int* in_sizes, int n_in, void* d_out, int out_size, void* d_ws, size_t ws_size, hipStream_t stream) {
    static int grid = 0;
    if (grid == 0) {
        if (n_in != 19 || out_size != M * DM || ws_size < WS_END) { fprintf(stderr, "kernel_launch: unexpected problem (n_in %d, out %d, ws %zu < %zu)\n", n_in, out_size, ws_size, (size_t)WS_END); grid = -1; return; }
        int dev = 0, cus = 0, per_cu = 0;
        if (hipGetDevice(&dev) != hipSuccess || hipDeviceGetAttribute(&cus, hipDeviceAttributeMultiprocessorCount, dev) != hipSuccess) { grid = -1; return; }
        if (hipFuncSetAttribute((const void*)fwd_kernel, hipFuncAttributeMaxDynamicSharedMemorySize, LDS_BYTES) != hipSuccess) { fprintf(stderr, "kernel_launch: hipFuncSetAttribute failed\n"); grid = -1; return; }
        if (hipOccupancyMaxActiveBlocksPerMultiprocessor(&per_cu, (const void*)fwd_kernel, NTHREADS, LDS_BYTES) != hipSuccess || per_cu < 1) fprintf(stderr, "kernel_launch: occupancy query says %d\n", per_cu);
        (void)hipGetLastError();
        if (cus < 256) { fprintf(stderr, "kernel_launch: %d CUs, this kernel is laid out for 256 (MI355X)\n", cus); grid = -1; return; }
        grid = 256;
    }
    if (grid < 0) return;
    if (hipMemsetAsync((char*)d_ws + WS_CTL, 0, CTL_ZERO_BYTES, stream) != hipSuccess) return;
    Args a{};
    for (int i = 0; i < 19; ++i) a.in[i] = (const float*)d_in[i];
    a.out = (float*)d_out; a.ws = (unsigned char*)d_ws;
#if MK_LAUNCH_PER_STEP
    for (int s = 0; s < NSTEPS; ++s) { a.s_lo = s; a.s_hi = s + 1; hipLaunchKernelGGL(fwd_kernel, dim3(grid), dim3(NTHREADS), LDS_BYTES, stream, a); }
#else
    a.s_lo = 0; a.s_hi = NSTEPS;
    hipLaunchKernelGGL(fwd_kernel, dim3(grid), dim3(NTHREADS), LDS_BYTES, stream, a);
#endif
}
```
